# Optimizing an MI355X kernel written in HIP

```python
import jax, jax.numpy as jnp
from jax import lax
import numpy as np

D_MODEL = 2048
BATCH = 2
SEQ = 8192
DEPTH = 1

CHUNK = 128
A_HEADS = 8
A_WIDTH = D_MODEL
A_HEAD_DIM = A_WIDTH // A_HEADS
B_GROUPS = 16
B_WIDTH = D_MODEL
CONV_WIDTH = 3
N_BRANCH = 2
DN_ALPHA = (2.0 * DEPTH) ** 0.25
DN_BETA = (8.0 * DEPTH) ** -0.25
LN_EPS = 1e-5
IN_WIDTHS = (A_WIDTH, A_WIDTH, A_WIDTH, B_WIDTH, B_WIDTH, B_WIDTH, B_WIDTH, D_MODEL, D_MODEL)
IN_COLS = 3 * A_WIDTH + 4 * B_WIDTH + N_BRANCH * D_MODEL

kernel_name = "hybrid_gated_sgu_shortconv_deepnorm"


def _split_points():
    pts, acc = [], 0
    for w in IN_WIDTHS[:-1]:
        acc += w
        pts.append(acc)
    return pts


def layer_norm(x, g, b):
    xf = x.astype(jnp.float32)
    mu = jnp.mean(xf, axis=-1, keepdims=True)
    var = jnp.mean(jnp.square(xf - mu), axis=-1, keepdims=True)
    y = (xf - mu) * lax.rsqrt(var + LN_EPS)
    return (y * g.astype(jnp.float32) + b.astype(jnp.float32)).astype(x.dtype)


def chunked_sgu(u, v, ln_g, ln_b, w_s, b_s):
    bsz, s, _ = u.shape
    nc = s // CHUNK
    u = jax.nn.gelu(u).reshape(bsz, nc, CHUNK, A_HEADS, A_HEAD_DIM)
    v = jax.nn.gelu(v).reshape(bsz, nc, CHUNK, A_HEADS, A_HEAD_DIM)
    v = layer_norm(v, ln_g.reshape(A_HEADS, A_HEAD_DIM), ln_b.reshape(A_HEADS, A_HEAD_DIM))
    causal = jnp.tril(jnp.ones((CHUNK, CHUNK), dtype=bool))
    w = jnp.where(causal[None], w_s, jnp.zeros_like(w_s))
    mixed = jnp.einsum('hts,bcshd->bcthd', w, v)
    mixed = mixed + jnp.transpose(b_s)[None, None, :, :, None]
    return (u * mixed).reshape(bsz, s, A_WIDTH)


def short_gated_conv(xb, cb, bb, conv_w, conv_b):
    s = xb.shape[1]
    h = cb * xb
    hp = jnp.pad(h, ((0, 0), (CONV_WIDTH - 1, 0), (0, 0)))
    conv = conv_b + conv_w[0] * hp[:, 0:s, :]
    for k in range(1, CONV_WIDTH):
        conv = conv + conv_w[k] * hp[:, k:k + s, :]
    return bb * conv


def setup_inputs(seed: int = 0) -> dict:
    key = jax.random.key(seed)
    ks = jax.random.split(key, 16)
    nrm = jax.random.normal
    x = nrm(ks[0], (BATCH, SEQ, D_MODEL), jnp.float32)
    w_in = nrm(ks[1], (DEPTH, D_MODEL, IN_COLS), jnp.float32) * D_MODEL ** -0.5
    b_gate = 0.02 * nrm(ks[2], (DEPTH, N_BRANCH * D_MODEL), jnp.float32)
    ln_v_g = 1.0 + 0.02 * nrm(ks[3], (DEPTH, A_WIDTH), jnp.float32)
    ln_v_b = 0.02 * nrm(ks[4], (DEPTH, A_WIDTH), jnp.float32)
    w_s = nrm(ks[5], (DEPTH, A_HEADS, CHUNK, CHUNK), jnp.float32) * (0.5 * CHUNK ** -0.5)
    b_s = 1.0 + 0.02 * nrm(ks[6], (DEPTH, A_HEADS, CHUNK), jnp.float32)
    conv_w = nrm(ks[7], (DEPTH, CONV_WIDTH, B_WIDTH), jnp.float32) * CONV_WIDTH ** -0.5
    conv_b = 0.02 * nrm(ks[8], (DEPTH, B_WIDTH), jnp.float32)
    w_oa = nrm(ks[9], (DEPTH, A_WIDTH, D_MODEL), jnp.float32) * (A_WIDTH ** -0.5 * DN_BETA)
    w_ob = nrm(ks[10], (DEPTH, B_WIDTH, D_MODEL), jnp.float32) * (B_WIDTH ** -0.5 * DN_BETA)
    w_out = nrm(ks[11], (DEPTH, D_MODEL, D_MODEL), jnp.float32) * (D_MODEL ** -0.5 * DN_BETA)
    ln_g = 1.0 + 0.02 * nrm(ks[12], (DEPTH, D_MODEL), jnp.float32)
    ln_b = 0.02 * nrm(ks[13], (DEPTH, D_MODEL), jnp.float32)
    return {"x": x, "w_in": w_in, "b_gate": b_gate, "ln_v_g": ln_v_g, "ln_v_b": ln_v_b,
            "w_s": w_s, "b_s": b_s, "conv_w": conv_w, "conv_b": conv_b,
            "w_oa": w_oa, "w_ob": w_ob, "w_out": w_out, "ln_g": ln_g, "ln_b": ln_b}


def reference(x, w_in, b_gate, ln_v_g, ln_v_b, w_s, b_s, conv_w, conv_b,
              w_oa, w_ob, w_out, ln_g, ln_b):
    splits = _split_points()
    for l in range(DEPTH):
        p = jnp.einsum('bsd,dc->bsc', x, w_in[l])
        ua, va, za, xb, cb, bb, zb, ga, gb = jnp.split(p, splits, axis=-1)
        ya = chunked_sgu(ua, va, ln_v_g[l], ln_v_b[l], w_s[l], b_s[l]) * jax.nn.silu(za)
        yb = short_gated_conv(xb, cb, bb, conv_w[l], conv_b[l]) * jax.nn.silu(zb)
        gate_a = jax.nn.sigmoid(ga + b_gate[l, :D_MODEL])
        gate_b = jax.nn.sigmoid(gb + b_gate[l, D_MODEL:])
        merged = (gate_a * jnp.einsum('bse,ed->bsd', ya, w_oa[l])
                  + gate_b * jnp.einsum('bse,ed->bsd', yb, w_ob[l]))
        out = jnp.einsum('bsd,de->bse', merged, w_out[l])
        x = layer_norm(DN_ALPHA * x + out, ln_g[l], ln_b[l])
    return x
```

```cpp
#include <hip/hip_runtime.h>
#include <cstdio>
#include <cstdint>

#ifndef MK_SP2
#define MK_SP2 1
#endif
#ifndef MK_ALIGN
#define MK_ALIGN 1
#endif
#ifndef MK_SYNC_K
#define MK_SYNC_K 0
#endif
#ifndef MK_EPI2
#define MK_EPI2 0
#endif
#ifndef MK_WGM1
#define MK_WGM1 4
#endif
#ifndef MK_WGM1B
#define MK_WGM1B 4
#endif
#ifndef MK_WGM3
#define MK_WGM3 4
#endif
#ifndef MK_WGM4
#define MK_WGM4 4
#endif
#ifndef MK_KS2_DIV
#define MK_KS2_DIV 1
#endif
#ifndef MK_KS2_MOD
#define MK_KS2_MOD 1
#endif
#ifndef MK_KS2_MUL
#define MK_KS2_MUL 0
#endif
#ifndef MK_PNROT
#define MK_PNROT 0
#endif
#ifndef MK_NT1
#define MK_NT1 0
#endif
#ifndef MK_NT1B
#define MK_NT1B 0
#endif
#ifndef MK_NT3
#define MK_NT3 0
#endif
#ifndef MK_NT4
#define MK_NT4 0
#endif
#ifndef MK_QPAIR
#define MK_QPAIR 1
#endif
#ifndef MK_F16S
#define MK_F16S 1
#endif
#ifndef MK_NTST
#define MK_NTST 0
#endif
#ifndef MK_P5XH
#define MK_P5XH 1
#endif
#ifndef MK_F16M
#define MK_F16M 0
#endif
#ifndef MK_P0BAL
#define MK_P0BAL 1
#endif
#ifndef MK_P4REV
#define MK_P4REV 0
#endif
#ifndef MK_P2HALF
#define MK_P2HALF 0
#endif
#ifndef MK_KSTAG
#define MK_KSTAG 1
#endif
#ifndef MK_NBI
#define MK_NBI 28
#endif
#ifndef MK_N_LAUNCHES
#define MK_N_LAUNCHES 1
#endif

#define LAS __attribute__((address_space(3)))
#define GAS __attribute__((address_space(1)))
typedef unsigned short bf16_t;
typedef short bf16x8 __attribute__((ext_vector_type(8)));
typedef float f32x4 __attribute__((ext_vector_type(4)));
typedef float f32x2 __attribute__((ext_vector_type(2)));
typedef unsigned u32x4 __attribute__((ext_vector_type(4)));
typedef unsigned u32x2 __attribute__((ext_vector_type(2)));

constexpr int M = 16384, D = 2048, NC = 18432, SEQ = 8192;
constexpr float LN_EPS = 1e-5f;
constexpr float DN_ALPHA = 1.189207115002721f;
constexpr int NPH = 6;

constexpr size_t MiB = 1u << 20;
constexpr size_t WS_CTL = 0, CTL_ZERO_BYTES = 64 * 1024;
constexpr size_t WS_WOA = 1 * MiB, WS_WOB = 9 * MiB, WS_WOUT = 17 * MiB;
constexpr size_t WS_WI8 = 25 * MiB;
constexpr size_t WS_WBF = 61 * MiB;
constexpr size_t WS_XB = 93 * MiB;
constexpr size_t WS_XQ = 157 * MiB;
constexpr size_t WS_EW = 189 * MiB, WS_GVT = 253 * MiB, WS_YB = 317 * MiB;
constexpr size_t WS_FIX = 381 * MiB;
constexpr size_t WS_SX = 383 * MiB, WS_SW = 384 * MiB;
constexpr size_t WS_RT = 441 * MiB, WS_GB = 505 * MiB;
constexpr size_t WS_YA = 25 * MiB;
constexpr size_t WS_MG = 189 * MiB;
constexpr size_t WS_OUTB = 253 * MiB;
constexpr size_t WS_END = 569 * MiB;

constexpr int RING_BYTES = 131072;
constexpr int LDSCTL_OFF = 163840 - 512, MISC_OFF = LDSCTL_OFF + 320;
constexpr int LDS_BYTES = 163840;
constexpr int HL_OFF = RING_BYTES, HL_PITCH = 136;

typedef __bf16 bf16x2_t __attribute__((ext_vector_type(2)));
__device__ __forceinline__ unsigned cvt_pk_bf16(float lo, float hi) { const bf16x2_t v = __builtin_convertvector((f32x2){lo, hi}, bf16x2_t); return __builtin_bit_cast(unsigned, v); }
typedef _Float16 f16x2_t __attribute__((ext_vector_type(2)));
__device__ __forceinline__ unsigned cvt_pk_f16(float lo, float hi) { const f16x2_t v = __builtin_convertvector((f32x2){lo, hi}, f16x2_t); return __builtin_bit_cast(unsigned, v); }
__device__ __forceinline__ f32x2 h2f(unsigned w) { return __builtin_convertvector(__builtin_bit_cast(f16x2_t, w), f32x2); }
typedef _Float16 f16x8 __attribute__((ext_vector_type(8)));
#define MFMA_F16(a, b, c) __builtin_amdgcn_mfma_f32_16x16x32_f16(__builtin_bit_cast(f16x8, a), __builtin_bit_cast(f16x8, b), c, 0, 0, 0)
#define MFMA_BF16(a, b, c) __builtin_amdgcn_mfma_f32_16x16x32_bf16(a, b, c, 0, 0, 0)
#if MK_F16M
#define OP_PK(lo, hi) cvt_pk_f16(lo, hi)
#else
#define OP_PK(lo, hi) cvt_pk_bf16(lo, hi)
#endif
#if MK_F16S
#define MFMA_16(a, b, c) __builtin_amdgcn_mfma_f32_16x16x32_f16(__builtin_bit_cast(f16x8, a), __builtin_bit_cast(f16x8, b), c, 0, 0, 0)
#else
#define MFMA_16(a, b, c) __builtin_amdgcn_mfma_f32_16x16x32_bf16(a, b, c, 0, 0, 0)
#endif
#if MK_F16S
#define ST_PK(lo, hi) cvt_pk_f16(lo, hi)
#define ST_LO(w) (h2f(w).x)
#define ST_HI(w) (h2f(w).y)
#else
#define ST_PK(lo, hi) cvt_pk_bf16(lo, hi)
#define ST_LO(w) bf_lo(w)
#define ST_HI(w) bf_hi(w)
#endif
#if MK_NTST
#define NT_ST(p, v) __builtin_nontemporal_store((v), (p))
#else
#define NT_ST(p, v) (*(p) = (v))
#endif
__device__ __forceinline__ float bf_lo(unsigned w) { return __builtin_bit_cast(float, w << 16); }
__device__ __forceinline__ float bf_hi(unsigned w) { return __builtin_bit_cast(float, w & 0xffff0000u); }
__device__ __forceinline__ float ex2(float x) { return __builtin_amdgcn_exp2f(x); }
__device__ __forceinline__ float rcp(float x) { return __builtin_amdgcn_rcpf(x); }
constexpr float LOG2E = 1.4426950408889634f;
constexpr float GELU_C1 = -(float)(1.5957691216057308 * 1.4426950408889634);
constexpr float GELU_C3 = -(float)(1.5957691216057308 * 1.4426950408889634 * 0.044715);
__device__ __forceinline__ float gelu_den(float x) { return 1.0f + ex2(x * (GELU_C1 + GELU_C3 * x * x)); }
__device__ __forceinline__ float sig_den(float x) { return 1.0f + ex2(-LOG2E * x); }

#define VM_WAIT() asm volatile("s_waitcnt vmcnt(0)" ::: "memory")
#define LDS_BARRIER() asm volatile("s_waitcnt lgkmcnt(0)\n\ts_barrier" ::: "memory")
#define LDS_WAIT() asm volatile("s_waitcnt lgkmcnt(0)" ::: "memory")

#define XB_TMO      128
#define XB_XCNT(j)  (256  + 64 * (j))
#define XB_XSUB(j)  (1280 + 64 * (j))
#define XB_XGEN(j)  (2304 + 64 * (j))
#define XB_TOP      3328
#define XB_TOPGEN   3392
#define XCD_BAR_WORDS 3456
#define XB_SPIN_CAP (1u << 18)
__device__ __forceinline__ unsigned xb_ld(unsigned* p)              { return __hip_atomic_load(p, __ATOMIC_RELAXED, __HIP_MEMORY_SCOPE_AGENT); }
__device__ __forceinline__ unsigned xb_add(unsigned* p, unsigned v) { return __hip_atomic_fetch_add(p, v, __ATOMIC_RELAXED, __HIP_MEMORY_SCOPE_AGENT); }
__device__ __forceinline__ unsigned xb_xcc_id() { return (unsigned)__builtin_amdgcn_s_getreg((3 << 11) | 20) & 0xFu; }
#define XB_SPIN(cond, bar) do { unsigned _sp = 0; while (cond) { __builtin_amdgcn_s_sleep(1); \
    if ((++_sp & 255u) == 0u) { if (xb_ld(&(bar)[XB_TMO])) break; if (_sp > XB_SPIN_CAP) { atomicAdd(&(bar)[XB_TMO], 1u); break; } } } } while (0)
struct XcdBarrier { unsigned* bar; unsigned x; volatile LAS unsigned* st; };
__device__ __forceinline__ XcdBarrier xcd_barrier_post(unsigned* bar, volatile LAS unsigned* st) {
    XcdBarrier b; b.bar = bar; b.x = xb_xcc_id(); b.st = st;
    if (threadIdx.x == 0) (void)xb_add(&bar[XB_XCNT(b.x)], 1u);
    return b;
}
__device__ __forceinline__ void xcd_barrier_complete(unsigned* bar, unsigned x, unsigned& nloc, unsigned& nx) {
    const unsigned G = gridDim.x * gridDim.y * gridDim.z;
    unsigned sum, cnt, mine, sp = 0u;
    for (;;) {
        sum = 0u; cnt = 0u; mine = 0u;
#pragma unroll
        for (unsigned j = 0; j < 16; ++j) { const unsigned c = xb_ld(&bar[XB_XCNT(j)]); sum += c; cnt += (c > 0u) ? 1u : 0u; mine = (j == x) ? c : mine; }
        if (sum == G) break;
        __builtin_amdgcn_s_sleep(1);
        if ((++sp & 255u) == 0u) { if (xb_ld(&bar[XB_TMO])) break; if (sp > XB_SPIN_CAP) { atomicAdd(&bar[XB_TMO], 1u); break; } }
    }
    nloc = mine > 0u ? mine : 1u; nx = cnt > 0u ? cnt : 1u;
}
__device__ __forceinline__ void xcd_barrier(const XcdBarrier& b) {
    asm volatile("s_waitcnt vmcnt(0)" ::: "memory");
    __syncthreads();
    if (threadIdx.x == 0) {
        unsigned* bar = b.bar;
        __builtin_amdgcn_s_waitcnt(0);
        unsigned nloc = b.st[0], nx = b.st[1];
        if (nloc == 0u) { xcd_barrier_complete(bar, b.x, nloc, nx); b.st[0] = nloc; b.st[1] = nx; }
        const unsigned old = xb_add(&bar[XB_XSUB(b.x)], 1u);
        const unsigned gen = old / nloc;
        if (old + 1u == (gen + 1u) * nloc) {
            __builtin_amdgcn_fence(__ATOMIC_RELEASE, "agent");
            asm volatile("s_waitcnt vmcnt(0)" ::: "memory");
            const unsigned og = xb_add(&bar[XB_TOP], 1u);
            const unsigned tg = og / nx;
            if (og + 1u == (tg + 1u) * nx) xb_add(&bar[XB_TOPGEN], 1u);
            else XB_SPIN(xb_ld(&bar[XB_TOPGEN]) == tg, bar);
            __builtin_amdgcn_fence(__ATOMIC_ACQUIRE, "agent");
            xb_add(&bar[XB_XGEN(b.x)], 1u);
            asm volatile("s_waitcnt vmcnt(0)" ::: "memory");
        } else {
            XB_SPIN(xb_ld(&bar[XB_XGEN(b.x)]) == gen, bar);
            __builtin_amdgcn_fence(__ATOMIC_ACQUIRE, "agent");
            asm volatile("s_waitcnt vmcnt(0)" ::: "memory");
        }
    }
    __syncthreads();
}

namespace pg8 {
constexpr int BM = 256, BK = 64, HALF = 128, HTB = HALF * BK * 2, STAGE_BYTES = 8 * HTB, NXCD = 8, KD = 2048;
__device__ __forceinline__ int lds_byte(int r, int c) { const int st = (r >> 4) * 2 + (c >> 5), rr = r & 15, cc = c & 31, ob = rr * 64 + cc * 2; return st * 1024 + (ob ^ (((ob >> 9) & 1) << 5)); }
__device__ __forceinline__ void stage_rc(int b, int& R, int& C) { const int st = b / 1024, sb = b % 1024, swz = sb ^ (((sb >> 9) & 1) << 5); R = (st >> 1) * 16 + swz / 64; C = (st & 1) * 32 + (swz % 64) / 2; }
__device__ __forceinline__ int perm32(int rho) { const int n = rho >> 4, i = rho & 15; return 8 * (i >> 2) + 4 * n + (i & 3); }

struct Unit { const char* A; const char* B; int kind, pm, pn; };
typedef int i32x8 __attribute__((ext_vector_type(8)));
typedef int i32x4v __attribute__((ext_vector_type(4)));
template <bool F8, bool I8> struct FragSel { typedef bf16x8 type; };
template <> struct FragSel<true, false> { typedef i32x8 type; };
template <> struct FragSel<false, true> { typedef i32x4v type; };
template <bool I8> struct AccSel { typedef f32x4 type; };
template <> struct AccSel<true> { typedef i32x4v type; };

__device__ __forceinline__ void tile_of(int L, int nM, int nN, int& pm, int& pn, const int WGM = 8) {
    const int nwg = nM * nN; int wgid = L;
    { const int q = nwg / NXCD, r = nwg % NXCD, xcd = wgid % NXCD, off = wgid / NXCD; wgid = (xcd < r ? xcd * (q + 1) : r * (q + 1) + (xcd - r) * q) + off; }
    const int nig = WGM * nN, gid = wgid / nig, fm = gid * WGM, gsz = (nM - fm) < WGM ? (nM - fm) : WGM;
    pm = fm + ((wgid % nig) % gsz); pn = (wgid % nig) / gsz;
}

template <class Prog>
__device__ __forceinline__ void gemm_phase(LAS unsigned char* lds, const Prog& P) {
    int tid = threadIdx.x; asm volatile("" : "+v"(tid));
    const int wid = __builtin_amdgcn_readfirstlane(tid >> 6), lane = tid & 63, wr = wid >> 2, wc = wid & 3, fr = lane & 15, fq = lane >> 4;
    constexpr bool FP8 = Prog::FP8;
    constexpr bool I8 = Prog::I8;
    constexpr int PB = (FP8 || I8) ? KD : 2 * KD, nt = (FP8 || I8) ? KD / 128 : KD / BK;
    using FragT = typename FragSel<FP8, I8>::type; using AccT = typename AccSel<I8>::type; constexpr int NF = FP8 ? 1 : 2;
    unsigned voffA[2], voffB[2];
#pragma unroll
    for (int i = 0; i < 2; ++i) { int R, C; stage_rc(tid * 16 + i * 8192, R, C); const int Rb = (R & ~31) + perm32(R & 31);
        voffA[i] = (unsigned)(R * PB + C * 2); voffB[i] = (unsigned)(Rb * PB + C * 2); }
    const size_t kstep = (size_t)(BK * 2);
    const size_t hstep = (size_t)HALF * PB;
    const unsigned ldsw = (unsigned)wid * 1024u;
    const int aoff = lds_byte(wr * 64 + fr, fq * 8), boff = lds_byte(wc * 32 + fr, fq * 8);
#define PG8_SA(b, h) (((b) * 2 + (h)) * HTB)
#define PG8_SB(b, h) ((4 + (b) * 2 + (h)) * HTB)
#define PG8_STAGE(bufoff, gbase, voff) do { _Pragma("unroll") for (int _i = 0; _i < 2; ++_i) { \
        if ((bufoff) < 4 * HTB) __builtin_amdgcn_global_load_lds((const unsigned*)((const char*)(gbase) + (voff)[_i]), (LAS unsigned*)(lds + (bufoff) + ldsw + _i * 8192), 16, 0, Prog::NT_A); \
        else __builtin_amdgcn_global_load_lds((const unsigned*)((const char*)(gbase) + (voff)[_i]), (LAS unsigned*)(lds + (bufoff) + ldsw + _i * 8192), 16, 0, Prog::NT_B); } } while (0)
#define PG8_LDA(dst, b, h) do { _Pragma("unroll") for (int m = 0; m < 4; ++m) { \
        if constexpr (FP8) { dst[m][0].lo = *(const LAS i32x4v*)(lds + PG8_SA(b, h) + aoff + m * 2048); dst[m][0].hi = *(const LAS i32x4v*)(lds + PG8_SA(b, h) + aoff + m * 2048 + 1024); } \
        else { _Pragma("unroll") for (int k = 0; k < 2; ++k) dst[m][k] = *(const LAS FragT*)(lds + PG8_SA(b, h) + aoff + m * 2048 + k * 1024); } } } while (0)
#define PG8_LDB(dst, b, h) do { _Pragma("unroll") for (int n = 0; n < 2; ++n) { \
        if constexpr (FP8) { dst[n][0].lo = *(const LAS i32x4v*)(lds + PG8_SB(b, h) + boff + n * 2048); dst[n][0].hi = *(const LAS i32x4v*)(lds + PG8_SB(b, h) + boff + n * 2048 + 1024); } \
        else { _Pragma("unroll") for (int k = 0; k < 2; ++k) dst[n][k] = *(const LAS FragT*)(lds + PG8_SB(b, h) + boff + n * 2048 + k * 1024); } } } while (0)
#define PG8_MMA(ai, bj, At, Bt) do { __builtin_amdgcn_s_setprio(1); _Pragma("unroll") for (int m = 0; m < 4; ++m) _Pragma("unroll") for (int n = 0; n < 2; ++n) { \
        if constexpr (FP8) asm volatile("v_mfma_scale_f32_16x16x128_f8f6f4 %0, %1, %2, %0, %3, %4 op_sel_hi:[0,0,0]" : "+v"(acc[ai][bj][m][n]) : "v"(Bt[n][0]), "v"(At[m][0]), "v"(scl_b), "v"(scl_a));   \
        else if constexpr (I8) { _Pragma("unroll") for (int k = 0; k < 2; ++k) acc[ai][bj][m][n] = __builtin_amdgcn_mfma_i32_16x16x64_i8(Bt[n][k], At[m][k], acc[ai][bj][m][n], 0, 0, 0); } \
        else { _Pragma("unroll") for (int k = 0; k < 2; ++k) acc[ai][bj][m][n] = (Prog::F16 ? MFMA_F16(Bt[n][k], At[m][k], acc[ai][bj][m][n]) : MFMA_BF16(Bt[n][k], At[m][k], acc[ai][bj][m][n])); } } \
        __builtin_amdgcn_s_setprio(0); } while (0)
#define PG8_WAIT_V(n) asm volatile("s_waitcnt vmcnt(" #n ")" ::: "memory")
#define PG8_WAIT_L(n) asm volatile("s_waitcnt lgkmcnt(" #n ")" ::: "memory")
#define PG8_BAR __builtin_amdgcn_s_barrier()
#define PG8_SCHED __builtin_amdgcn_sched_barrier(0)
    Unit cur, nxt; int ui = 0;
    if (!P.next(0, cur)) return;
    AccT acc[2][2][4][2];
#pragma unroll
    for (int a = 0; a < 2; ++a)
#pragma unroll
        for (int b = 0; b < 2; ++b)
#pragma unroll
            for (int m = 0; m < 4; ++m)
#pragma unroll
                for (int n = 0; n < 2; ++n) acc[a][b][m][n] = (AccT){0, 0, 0, 0};
    FragT At[4][NF], B0[2][NF], B1[2][NF];
    const int scl_a = Prog::SCALE_A, scl_b = Prog::SCALE_B; (void)scl_a; (void)scl_b;
    const char* cA = cur.A; const char* cB = cur.B;
    const int k0s = MK_KSTAG ? ((int)(blockIdx.x % NXCD) * 2 * MK_KSTAG + (((int)(blockIdx.x / NXCD) / MK_KS2_DIV) % MK_KS2_MOD) * MK_KS2_MUL) * (nt / 16) : 0;
#define PG8_KO(t) ((size_t)(((t) + k0s) & (nt - 1)) * kstep)
#if MK_SP2
    PG8_STAGE(PG8_SB(0, 0), cB + PG8_KO(0), voffB); PG8_STAGE(PG8_SB(0, 1), cB + PG8_KO(0) + hstep, voffB); PG8_STAGE(PG8_SA(0, 0), cA + PG8_KO(0), voffA); PG8_STAGE(PG8_SA(0, 1), cA + PG8_KO(0) + hstep, voffA);
    if (wr == 1) PG8_BAR;
    PG8_WAIT_V(2); PG8_BAR;
    PG8_STAGE(PG8_SB(1, 0), cB + PG8_KO(1), voffB); PG8_STAGE(PG8_SA(1, 0), cA + PG8_KO(1), voffA); PG8_STAGE(PG8_SB(1, 1), cB + hstep + PG8_KO(1), voffB);
    PG8_WAIT_V(6); PG8_BAR;
#else
    PG8_STAGE(PG8_SB(0, 0), cB, voffB); PG8_STAGE(PG8_SA(0, 0), cA, voffA); PG8_STAGE(PG8_SB(0, 1), cB + hstep, voffB); PG8_STAGE(PG8_SA(0, 1), cA + hstep, voffA);
    if (wr == 1) PG8_BAR;
    PG8_WAIT_V(4); PG8_BAR;
    PG8_STAGE(PG8_SB(1, 0), cB + kstep, voffB); PG8_STAGE(PG8_SA(1, 0), cA + kstep, voffA); PG8_STAGE(PG8_SB(1, 1), cB + hstep + kstep, voffB);
    PG8_WAIT_V(6); PG8_BAR;
#endif
    for (;;) {
        const bool has_next = P.next(ui + 1, nxt);
        const char* nA = has_next ? nxt.A : cA; const char* nB = has_next ? nxt.B : cB;
        for (int t = 0; t < nt; t += 2) {
            const bool last = (t == nt - 2);
            const char* a1 = cA + PG8_KO(t + 1);
            const char* a2 = (last ? nA : cA) + PG8_KO(t + 2); const char* b2 = (last ? nB : cB) + PG8_KO(t + 2);
            const char* a3 = (last ? nA : cA) + PG8_KO(t + 3); const char* b3 = (last ? nB : cB) + PG8_KO(t + 3);
#if MK_SP2
            PG8_LDB(B0, 0, 0); PG8_LDB(B1, 0, 1); PG8_SCHED; PG8_LDA(At, 0, 0); PG8_STAGE(PG8_SA(1, 1), a1 + hstep, voffA);
            PG8_WAIT_V(8); PG8_WAIT_L(0); PG8_BAR; PG8_MMA(0, 0, At, B0); PG8_MMA(0, 1, At, B1); PG8_BAR; PG8_SCHED;
            PG8_LDA(At, 0, 1); PG8_STAGE(PG8_SB(0, 0), b2, voffB); PG8_STAGE(PG8_SB(0, 1), b2 + hstep, voffB); PG8_STAGE(PG8_SA(0, 0), a2, voffA);
            PG8_WAIT_V(8); PG8_WAIT_L(0); PG8_BAR; PG8_MMA(1, 0, At, B0); PG8_MMA(1, 1, At, B1); PG8_BAR; PG8_SCHED;
            PG8_LDB(B0, 1, 0); PG8_LDB(B1, 1, 1); PG8_SCHED; PG8_LDA(At, 1, 0); PG8_STAGE(PG8_SA(0, 1), a2 + hstep, voffA);
            PG8_WAIT_V(8); PG8_WAIT_L(0); PG8_BAR; PG8_MMA(0, 0, At, B0); PG8_MMA(0, 1, At, B1); PG8_BAR; PG8_SCHED;
            PG8_LDA(At, 1, 1); PG8_STAGE(PG8_SB(1, 0), b3, voffB); PG8_STAGE(PG8_SB(1, 1), b3 + hstep, voffB); PG8_STAGE(PG8_SA(1, 0), a3, voffA);
            PG8_WAIT_V(8); PG8_WAIT_L(0); PG8_BAR; PG8_MMA(1, 0, At, B0); PG8_MMA(1, 1, At, B1); PG8_BAR; PG8_SCHED;
#else
            PG8_LDB(B0, 0, 0); PG8_SCHED; PG8_LDA(At, 0, 0); PG8_STAGE(PG8_SA(1, 1), a1 + hstep, voffA);
            PG8_WAIT_L(8); PG8_BAR; PG8_WAIT_L(0); PG8_MMA(0, 0, At, B0); PG8_BAR; PG8_SCHED;
            PG8_LDB(B1, 0, 1); PG8_STAGE(PG8_SB(0, 0), b2, voffB);
            PG8_BAR; PG8_WAIT_L(0); PG8_MMA(0, 1, At, B1); PG8_BAR;
            PG8_LDA(At, 0, 1); PG8_STAGE(PG8_SA(0, 0), a2, voffA);
            PG8_BAR; PG8_WAIT_L(0); PG8_MMA(1, 0, At, B0); PG8_BAR; PG8_SCHED;
            PG8_STAGE(PG8_SB(0, 1), b2 + hstep, voffB);
            PG8_WAIT_V(6); PG8_BAR; PG8_MMA(1, 1, At, B1); PG8_BAR;
            PG8_LDB(B0, 1, 0); PG8_SCHED; PG8_LDA(At, 1, 0); PG8_STAGE(PG8_SA(0, 1), a2 + hstep, voffA);
            PG8_WAIT_L(8); PG8_BAR; PG8_WAIT_L(0); PG8_MMA(0, 0, At, B0); PG8_BAR; PG8_SCHED;
            PG8_LDB(B1, 1, 1); PG8_STAGE(PG8_SB(1, 0), b3, voffB);
            PG8_BAR; PG8_WAIT_L(0); PG8_MMA(0, 1, At, B1); PG8_BAR;
            PG8_LDA(At, 1, 1); PG8_STAGE(PG8_SA(1, 0), a3, voffA);
            PG8_BAR; PG8_WAIT_L(0); PG8_MMA(1, 0, At, B0); PG8_BAR; PG8_SCHED;
            PG8_STAGE(PG8_SB(1, 1), b3 + hstep, voffB);
            PG8_WAIT_V(6); PG8_BAR; PG8_MMA(1, 1, At, B1); PG8_BAR;
#endif
        }
#if MK_ALIGN
        if (wr == 0) PG8_BAR;
#endif
        if constexpr (FP8) asm volatile("s_nop 15\n\ts_nop 15" ::: "memory");
        int z_e = 0; asm volatile("" : "+v"(z_e));
        const int lane_e = (int)__builtin_amdgcn_mbcnt_hi(~0u, __builtin_amdgcn_mbcnt_lo(~0u, (unsigned)z_e)), fr_e = lane_e & 15, fq_e = lane_e >> 4;
#if MK_EPI2
        if (Prog::EPI2) (void)P.epi(acc, cur, wr, wc, fr_e, fq_e);
#endif
        const bool keep = P.epi(acc, cur, wr, wc, fr_e, fq_e);
        if (!has_next) break;
        if (!keep) {
#pragma unroll
            for (int a = 0; a < 2; ++a)
#pragma unroll
                for (int b = 0; b < 2; ++b)
#pragma unroll
                    for (int m = 0; m < 4; ++m)
#pragma unroll
                        for (int n = 0; n < 2; ++n) acc[a][b][m][n] = (AccT){0, 0, 0, 0};
        }
        cur = nxt; cA = nA; cB = nB; ++ui;
#if MK_ALIGN
        if (wr == 1) PG8_BAR;
#endif
    }
    PG8_WAIT_V(0);
#if !MK_ALIGN
    if (wr == 0) PG8_BAR;
#endif
    PG8_BAR;
#undef PG8_SA
#undef PG8_SB
#undef PG8_STAGE
#undef PG8_LDA
#undef PG8_LDB
#undef PG8_MMA
#undef PG8_WAIT_V
#undef PG8_WAIT_L
#undef PG8_BAR
#undef PG8_SCHED
}
}

struct Frame {
    LAS unsigned char* lds;
    int tid, lane, wave, G, bx;
    const float *x, *w_in, *b_gate, *ln_v_g, *ln_v_b, *w_s, *b_s, *conv_w, *conv_b, *w_oa, *w_ob, *w_out, *ln_g, *ln_b;
    float* out;
    bf16_t *Win_t, *Woa_t, *Wob_t, *Wout_t, *Xb, *EW, *GVt, *FIX, *RT, *GBb, *YA, *YB, *MG, *OUTB;
    unsigned char *Wi8, *Xi8; float *SX, *SW;
};

__host__ __device__ __forceinline__ size_t gvt_index(int ch, int t) { return ((((size_t)(t >> 7) * 8 + (ch >> 8)) * 256 + (ch & 255)) << 7) + (t & 127); }

enum { K_EW = 0, K_GVT = 1, K_BU = 2, K_GATE = 4, K_MIDA = 5, K_MRG = 6, K_OUT = 7 };
struct ProgP1 {
    static constexpr bool EPI2 = true, FP8 = false, I8 = true; static constexpr int NT_A = (MK_NT1) & 3, NT_B = ((MK_NT1) >> 2) & 3; static constexpr bool F16 = false;
    static constexpr int SCALE_A = 0, SCALE_B = 0;
    const unsigned char *Xi8, *Wi8; const float *SX, *SW; bf16_t *EW, *GVt, *YB, *FIX, *RT, *GBb; const float *b_gate, *conv_w, *conv_b; LAS unsigned char* hl; int G, c; void* dbg;
    typedef pg8::i32x4v ivec;
    static __device__ __forceinline__ f32x2 ex2v(f32x2 x) { return (f32x2){ex2(x.x), ex2(x.y)}; }
    static __device__ __forceinline__ f32x2 rcpv(f32x2 x) { return (f32x2){rcp(x.x), rcp(x.y)}; }
    static __device__ __forceinline__ f32x2 sig_den2(f32x2 x) { return ex2v(x * (-LOG2E)) + 1.0f; }
    static __device__ __forceinline__ f32x2 gelu_den2(f32x2 x) { return ex2v(x * (x * x * GELU_C3 + GELU_C1)) + 1.0f; }
    static __device__ __forceinline__ f32x4 tof(ivec v) { return (f32x4){(float)v[0], (float)v[1], (float)v[2], (float)v[3]}; }
    __device__ __forceinline__ bool next(int i, pg8::Unit& u) const {
        constexpr int NPN = 40 + MK_NBI;
        const long L = (long)i * G + c; if (L >= 64 * NPN) return false;
        int pm, pn; pg8::tile_of((int)L, 64, NPN, pm, pn, MK_WGM1);
        if (MK_PNROT) pn = (pn + (c % 8) * (NPN / 8)) % NPN;
        pn = pn < 16 ? pn + 56 : pn - 16;
        u.pm = pm; u.pn = pn;
        const char* xp = (const char*)Xi8 + (size_t)pm * (256 * 2048); const char* wp = (const char*)Wi8 + (size_t)pn * (256 * 2048);
        if (pn < 16) { u.kind = K_EW; u.A = xp; u.B = wp; }
        else if (pn < 24) { u.kind = K_GVT; u.A = wp; u.B = xp; }
        else if (pn < 56) { u.kind = K_BU; u.A = xp; u.B = wp; }
        else { u.kind = K_GATE; u.A = xp; u.B = wp; }
        return true;
    }
    __device__ __forceinline__ bool epi(const ivec (&acc)[2][2][4][2], const pg8::Unit& u, int wr, int wc, int fr, int fq) const {
        const int rloc = wr * 64 + fr, cloc = wc * 32 + 8 * fq;
        const int kind = u.kind;
        if (kind == K_GVT) {
            bf16_t* base = GVt + ((((size_t)(2 * u.pm) * 8 + (u.pn - 16)) * 256 + rloc) << 7) + cloc;
            f32x4 sxc[2][2];
#pragma unroll
            for (int bj = 0; bj < 2; ++bj)
#pragma unroll
                for (int n = 0; n < 2; ++n) sxc[bj][n] = *(const f32x4*)(SX + u.pm * 256 + bj * 128 + cloc + 4 * n);
            const float* swp = SW + u.pn * 256 + rloc;
#pragma unroll
            for (int ai = 0; ai < 2; ++ai)
#pragma unroll
                for (int m = 0; m < 4; ++m) {
                    const float swr = swp[ai * 128 + m * 16];
#pragma unroll
                    for (int bj = 0; bj < 2; ++bj) {
                        const f32x4 a = tof(acc[ai][bj][m][0]) * sxc[bj][0] * swr, b = tof(acc[ai][bj][m][1]) * sxc[bj][1] * swr;
                        const f32x2 a01 = (f32x2){a[0], a[1]}, a23 = (f32x2){a[2], a[3]}, b01 = (f32x2){b[0], b[1]}, b23 = (f32x2){b[2], b[3]};
                        const f32x2 r0 = a01 * rcpv(gelu_den2(a01)), r1 = a23 * rcpv(gelu_den2(a23)), r2 = b01 * rcpv(gelu_den2(b01)), r3 = b23 * rcpv(gelu_den2(b23));
                        u32x4 w; w.x = ST_PK(r0.x, r0.y); w.y = ST_PK(r1.x, r1.y); w.z = ST_PK(r2.x, r2.y); w.w = ST_PK(r3.x, r3.y);
                        NT_ST((u32x4*)(base + (size_t)bj * (8 * 256 * 128) + (size_t)(ai * 128 + m * 16) * 128), (w));
                    }
                }
            return false;
        }
        f32x4 sw[2][2];
#pragma unroll
        for (int bj = 0; bj < 2; ++bj)
#pragma unroll
            for (int n = 0; n < 2; ++n) sw[bj][n] = *(const f32x4*)(SW + u.pn * 256 + bj * 128 + cloc + 4 * n);
        const float* sxp = SX + u.pm * 256 + rloc;
        if (kind == K_GATE) {
            const int ch = (u.pn - 56) * 128 + cloc;
            f32x4 ba[2], bb[2];
#pragma unroll
            for (int n = 0; n < 2; ++n) { ba[n] = *(const f32x4*)(b_gate + ch + 4 * n); bb[n] = *(const f32x4*)(b_gate + D + ch + 4 * n); }
            const size_t o0 = (size_t)(u.pm * 256 + rloc) * D + ch;
#pragma unroll
            for (int ai = 0; ai < 2; ++ai)
#pragma unroll
                for (int m = 0; m < 4; ++m) {
                    const float sxr = sxp[ai * 128 + m * 16];
                    unsigned w1[4], w2[4];
#pragma unroll
                    for (int n = 0; n < 2; ++n) {
                        const f32x4 va = tof(acc[ai][0][m][n]) * (sw[0][n] * sxr) + ba[n], vb = tof(acc[ai][1][m][n]) * (sw[1][n] * sxr) + bb[n];
#pragma unroll
                        for (int jj = 0; jj < 2; ++jj) {
                            f32x2 xa = (f32x2){va[2 * jj], va[2 * jj + 1]}, xb = (f32x2){vb[2 * jj], vb[2 * jj + 1]};
                            xa.x = fminf(fmaxf(xa.x, -30.f), 30.f); xa.y = fminf(fmaxf(xa.y, -30.f), 30.f); xb.x = fminf(fmaxf(xb.x, -30.f), 30.f); xb.y = fminf(fmaxf(xb.y, -30.f), 30.f);
                            const f32x2 da = sig_den2(xa), db = sig_den2(xb);
                            const f32x2 rt = db * rcpv(da), gb = rcpv(db);
                            w1[2 * n + jj] = cvt_pk_bf16(rt.x, rt.y); w2[2 * n + jj] = cvt_pk_bf16(gb.x, gb.y);
                        }
                    }
                    const size_t o = o0 + (size_t)(ai * 128 + m * 16) * D;
                    NT_ST((u32x4*)(RT + o), ((u32x4){w1[0], w1[1], w1[2], w1[3]})); NT_ST((u32x4*)(GBb + o), ((u32x4){w2[0], w2[1], w2[2], w2[3]}));
                }
            return false;
        }
        if (kind == K_EW) {
            bf16_t* base = EW + (size_t)(u.pm * 256 + rloc) * D + u.pn * 128 + cloc;
#pragma unroll
            for (int ai = 0; ai < 2; ++ai)
#pragma unroll
                for (int m = 0; m < 4; ++m) {
                    const float sxr = sxp[ai * 128 + m * 16];
                    unsigned w[4];
#pragma unroll
                    for (int n = 0; n < 2; ++n) {
                        const f32x4 va = tof(acc[ai][0][m][n]) * (sw[0][n] * sxr), vb = tof(acc[ai][1][m][n]) * (sw[1][n] * sxr);
#pragma unroll
                        for (int jj = 0; jj < 2; ++jj) {
                            const f32x2 a = (f32x2){va[2 * jj], va[2 * jj + 1]}, b = (f32x2){vb[2 * jj], vb[2 * jj + 1]};
                            const f32x2 r = a * b * rcpv(gelu_den2(a) * sig_den2(b));
                            w[2 * n + jj] = ST_PK(r.x, r.y);
                        }
                    }
                    NT_ST((u32x4*)(base + (size_t)(ai * 128 + m * 16) * D), ((u32x4){w[0], w[1], w[2], w[3]}));
                }
            return false;
        }
        epi_bu(acc, u, sw, sxp, wr, wc, fr, fq);
        return false;
    }
    __device__ __forceinline__ void epi_bu(const ivec (&acc)[2][2][4][2], const pg8::Unit& u, const f32x4 (&sw)[2][2], const float* sxp, int wr, int wc, int fr, int fq) const {
        const int ub = u.pn - 24, cu = 16 * wc + 4 * fq, ch = 64 * ub + cu;
        const f32x4 w0 = *(const f32x4*)(conv_w + ch), w1 = *(const f32x4*)(conv_w + D + ch), w2 = *(const f32x4*)(conv_w + 2 * D + ch), cb = *(const f32x4*)(conv_b + ch);
        bf16_t* HALO = FIX; bf16_t* H01 = FIX + 64 * 2 * D; bf16_t* G01 = FIX + 2 * 64 * 2 * D;
        LAS unsigned char* hrow = hl + (64 * wr + fr) * HL_PITCH + cu * 2;
#pragma unroll
        for (int ai = 0; ai < 2; ++ai) {
            u32x2 hw[4]; f32x4 gg[4];
#pragma unroll
            for (int m = 0; m < 4; ++m) {
                const float sxr = sxp[ai * 128 + m * 16];
                const f32x4 x = tof(acc[ai][0][m][0]) * (sw[0][0] * sxr), c = tof(acc[ai][0][m][1]) * (sw[0][1] * sxr), b = tof(acc[ai][1][m][0]) * (sw[1][0] * sxr), z = tof(acc[ai][1][m][1]) * (sw[1][1] * sxr);
                const f32x4 h = x * c;
                hw[m] = (u32x2){ST_PK(h[0], h[1]), ST_PK(h[2], h[3])};
                const f32x2 d01 = sig_den2((f32x2){z[0], z[1]}), d23 = sig_den2((f32x2){z[2], z[3]});
                const f32x2 g01 = (f32x2){b[0], b[1]} * (f32x2){z[0], z[1]} * rcpv(d01), g23 = (f32x2){b[2], b[3]} * (f32x2){z[2], z[3]} * rcpv(d23);
                const u32x2 gw = (u32x2){ST_PK(g01.x, g01.y), ST_PK(g23.x, g23.y)};
                gg[m] = (f32x4){ST_LO(gw.x), ST_HI(gw.x), ST_LO(gw.y), ST_HI(gw.y)};
                *(LAS u32x2*)(hrow + (2 + 16 * m) * HL_PITCH) = hw[m];
                if (ai == 0 && wr == 0 && m == 0 && fr < 2) {
                    *(u32x2*)(H01 + ((size_t)u.pm * 2 + fr) * D + ch) = hw[m]; *(u32x2*)(G01 + ((size_t)u.pm * 2 + fr) * D + ch) = gw; }
                if (ai == 1 && wr == 1 && m == 3 && fr >= 14) *(u32x2*)(HALO + ((size_t)u.pm * 2 + (fr - 14)) * D + ch) = hw[m];
            }
            if (ai == 1 && wr == 1 && fr >= 14) {
                const float sxr = sxp[48];
                const f32x4 h = (tof(acc[0][0][3][0]) * (sw[0][0] * sxr)) * (tof(acc[0][0][3][1]) * (sw[0][1] * sxr));
                *(LAS u32x2*)(hl + (fr - 14) * HL_PITCH + cu * 2) = (u32x2){ST_PK(h[0], h[1]), ST_PK(h[2], h[3])};
            }
            LDS_BARRIER();
            bf16_t* yrow = YB + (size_t)(u.pm * 256 + ai * 128 + 64 * wr + fr) * D + ch;
#pragma unroll
            for (int m = 0; m < 4; ++m) {
                const u32x2 a1 = *(const LAS u32x2*)(hrow + (1 + 16 * m) * HL_PITCH), a2 = *(const LAS u32x2*)(hrow + (16 * m) * HL_PITCH);
                const f32x4 h0 = (f32x4){ST_LO(hw[m].x), ST_HI(hw[m].x), ST_LO(hw[m].y), ST_HI(hw[m].y)};
                const f32x4 h1 = (f32x4){ST_LO(a1.x), ST_HI(a1.x), ST_LO(a1.y), ST_HI(a1.y)}, h2 = (f32x4){ST_LO(a2.x), ST_HI(a2.x), ST_LO(a2.y), ST_HI(a2.y)};
                const f32x4 y = gg[m] * (cb + w0 * h2 + w1 * h1 + w2 * h0);
                NT_ST((u32x2*)(yrow + (size_t)(16 * m) * D), ((u32x2){OP_PK(y[0], y[1]), OP_PK(y[2], y[3])}));
            }
            LDS_BARRIER();
        }
    }
};

struct ProgP1B {
    static constexpr bool EPI2 = false, FP8 = false, I8 = false; static constexpr int SCALE_A = 0, SCALE_B = 0; static constexpr void* dbg = nullptr; static constexpr int NT_A = (MK_NT1B) & 3, NT_B = ((MK_NT1B) >> 2) & 3; static constexpr bool F16 = (MK_F16S != 0);
    const bf16_t *Xb, *Wbf; bf16_t *YB, *FIX; const float *conv_w, *conv_b; LAS unsigned char* hl; int G, c;
    static __device__ __forceinline__ f32x2 ex2v(f32x2 x) { return (f32x2){ex2(x.x), ex2(x.y)}; }
    static __device__ __forceinline__ f32x2 rcpv(f32x2 x) { return (f32x2){rcp(x.x), rcp(x.y)}; }
    static __device__ __forceinline__ f32x2 sig_den2(f32x2 x) { return ex2v(x * (-LOG2E)) + 1.0f; }
    __device__ __forceinline__ bool next(int i, pg8::Unit& u) const {
        constexpr int NB = 32 - MK_NBI;
        const long L = (long)i * G + c; if (L >= 64 * NB) return false;
        int pm, pn; pg8::tile_of((int)L, 64, NB, pm, pn, MK_WGM1B); if (MK_PNROT) pn = (pn + (c % 8) * (NB / 8)) % NB; u.pm = pm; u.pn = 24 + MK_NBI + pn; u.kind = K_BU;
        u.A = (const char*)Xb + (size_t)pm * (256 * 2048 * 2); u.B = (const char*)Wbf + (size_t)(MK_NBI + pn) * (256 * 2048 * 2);
        return true;
    }
    __device__ __forceinline__ bool epi(const f32x4 (&acc)[2][2][4][2], const pg8::Unit& u, int wr, int wc, int fr, int fq) const {
        const int ub = u.pn - 24, cu = 16 * wc + 4 * fq, ch = 64 * ub + cu;
        const f32x4 w0 = *(const f32x4*)(conv_w + ch), w1 = *(const f32x4*)(conv_w + D + ch), w2 = *(const f32x4*)(conv_w + 2 * D + ch), cb = *(const f32x4*)(conv_b + ch);
        bf16_t* HALO = FIX; bf16_t* H01 = FIX + 64 * 2 * D; bf16_t* G01 = FIX + 2 * 64 * 2 * D;
        LAS unsigned char* hrow = hl + (64 * wr + fr) * HL_PITCH + cu * 2;
#pragma unroll
        for (int ai = 0; ai < 2; ++ai) {
            u32x2 hw[4]; f32x4 gg[4];
#pragma unroll
            for (int m = 0; m < 4; ++m) {
                const f32x4 x = acc[ai][0][m][0], c = acc[ai][0][m][1], b = acc[ai][1][m][0], z = acc[ai][1][m][1];
                const f32x4 h = x * c;
                hw[m] = (u32x2){ST_PK(h[0], h[1]), ST_PK(h[2], h[3])};
                const f32x2 d01 = sig_den2((f32x2){z[0], z[1]}), d23 = sig_den2((f32x2){z[2], z[3]});
                const f32x2 g01 = (f32x2){b[0], b[1]} * (f32x2){z[0], z[1]} * rcpv(d01), g23 = (f32x2){b[2], b[3]} * (f32x2){z[2], z[3]} * rcpv(d23);
                const u32x2 gw = (u32x2){ST_PK(g01.x, g01.y), ST_PK(g23.x, g23.y)};
                gg[m] = (f32x4){ST_LO(gw.x), ST_HI(gw.x), ST_LO(gw.y), ST_HI(gw.y)};
                *(LAS u32x2*)(hrow + (2 + 16 * m) * HL_PITCH) = hw[m];
                if (ai == 0 && wr == 0 && m == 0 && fr < 2) { *(u32x2*)(H01 + ((size_t)u.pm * 2 + fr) * D + ch) = hw[m]; *(u32x2*)(G01 + ((size_t)u.pm * 2 + fr) * D + ch) = gw; }
                if (ai == 1 && wr == 1 && m == 3 && fr >= 14) *(u32x2*)(HALO + ((size_t)u.pm * 2 + (fr - 14)) * D + ch) = hw[m];
            }
            if (ai == 1 && wr == 1 && fr >= 14) {
                const f32x4 h = acc[0][0][3][0] * acc[0][0][3][1];
                *(LAS u32x2*)(hl + (fr - 14) * HL_PITCH + cu * 2) = (u32x2){ST_PK(h[0], h[1]), ST_PK(h[2], h[3])};
            }
            LDS_BARRIER();
            bf16_t* yrow = YB + (size_t)(u.pm * 256 + ai * 128 + 64 * wr + fr) * D + ch;
#pragma unroll
            for (int m = 0; m < 4; ++m) {
                const u32x2 a1 = *(const LAS u32x2*)(hrow + (1 + 16 * m) * HL_PITCH), a2 = *(const LAS u32x2*)(hrow + (16 * m) * HL_PITCH);
                const f32x4 h0 = (f32x4){ST_LO(hw[m].x), ST_HI(hw[m].x), ST_LO(hw[m].y), ST_HI(hw[m].y)};
                const f32x4 h1 = (f32x4){ST_LO(a1.x), ST_HI(a1.x), ST_LO(a1.y), ST_HI(a1.y)}, h2 = (f32x4){ST_LO(a2.x), ST_HI(a2.x), ST_LO(a2.y), ST_HI(a2.y)};
                const f32x4 y = gg[m] * (cb + w0 * h2 + w1 * h1 + w2 * h0);
                NT_ST((u32x2*)(yrow + (size_t)(16 * m) * D), ((u32x2){OP_PK(y[0], y[1]), OP_PK(y[2], y[3])}));
            }
            LDS_BARRIER();
        }
        return false;
    }
};

struct ProgP3 {
    static constexpr bool EPI2 = false, FP8 = false, I8 = false; static constexpr int SCALE_A = 0, SCALE_B = 0; static constexpr void* dbg = nullptr; static constexpr int NT_A = (MK_NT3) & 3, NT_B = ((MK_NT3) >> 2) & 3; static constexpr bool F16 = (MK_F16M != 0);
    const bf16_t *YA, *YB, *Woa_t, *Wob_t, *RT, *GBb; bf16_t* MG; int G, c;
    __device__ __forceinline__ bool next(int i, pg8::Unit& u) const {
        const long L = (long)(i >> 1) * G + c; if (L >= 64 * 8) return false;
        int pm, pn; pg8::tile_of((int)L, 64, 8, pm, pn, MK_WGM3); u.pm = pm; u.pn = pn;
        const size_t ao = (size_t)pm * (256 * 2048 * 2), bo = (size_t)pn * (256 * 2048 * 2);
        if ((i & 1) == 0) { u.kind = K_MIDA; u.A = (const char*)YA + ao; u.B = (const char*)Woa_t + bo; }
        else { u.kind = K_MRG; u.A = (const char*)YB + ao; u.B = (const char*)Wob_t + bo; }
        return true;
    }
    __device__ __forceinline__ bool epi(f32x4 (&acc)[2][2][4][2], const pg8::Unit& u, int wr, int wc, int fr, int fq) const {
        const size_t o0 = (size_t)(u.pm * 256 + wr * 64 + fr) * D + u.pn * 256 + wc * 32 + 8 * fq;
        if (u.kind == K_MIDA) {
#pragma unroll
            for (int ai = 0; ai < 2; ++ai)
#pragma unroll
                for (int m = 0; m < 4; ++m)
#pragma unroll
                    for (int bj = 0; bj < 2; ++bj) {
                        const u32x4 r = *(const u32x4*)(RT + o0 + (size_t)(ai * 128 + m * 16) * D + bj * 128);
                        acc[ai][bj][m][0][0] *= bf_lo(r.x); acc[ai][bj][m][0][1] *= bf_hi(r.x); acc[ai][bj][m][0][2] *= bf_lo(r.y); acc[ai][bj][m][0][3] *= bf_hi(r.y);
                        acc[ai][bj][m][1][0] *= bf_lo(r.z); acc[ai][bj][m][1][1] *= bf_hi(r.z); acc[ai][bj][m][1][2] *= bf_lo(r.w); acc[ai][bj][m][1][3] *= bf_hi(r.w);
                    }
            return true;
        }
#pragma unroll
        for (int ai = 0; ai < 2; ++ai)
#pragma unroll
            for (int m = 0; m < 4; ++m)
#pragma unroll
                for (int bj = 0; bj < 2; ++bj) {
                    const size_t o = o0 + (size_t)(ai * 128 + m * 16) * D + bj * 128;
                    const u32x4 g = *(const u32x4*)(GBb + o);
                    const f32x4 a = acc[ai][bj][m][0], b = acc[ai][bj][m][1];
                    u32x4 w;
                    w.x = OP_PK(a[0] * bf_lo(g.x), a[1] * bf_hi(g.x)); w.y = OP_PK(a[2] * bf_lo(g.y), a[3] * bf_hi(g.y));
                    w.z = OP_PK(b[0] * bf_lo(g.z), b[1] * bf_hi(g.z)); w.w = OP_PK(b[2] * bf_lo(g.w), b[3] * bf_hi(g.w));
                    *(u32x4*)(MG + o) = w;
                }
        return false;
    }
};

struct ProgP4 {
    static constexpr bool EPI2 = false, FP8 = false, I8 = false; static constexpr int SCALE_A = 0, SCALE_B = 0; static constexpr void* dbg = nullptr; static constexpr int NT_A = (MK_NT4) & 3, NT_B = ((MK_NT4) >> 2) & 3; static constexpr bool F16 = (MK_F16M != 0);
    const bf16_t *MG, *Wout_t; bf16_t* OUTB; int G, c;
    __device__ __forceinline__ bool next(int i, pg8::Unit& u) const {
        const int nr = (64 * 8 + G - 1) / G;
        if (i >= nr) return false;
        const long L = (long)((MK_P4REV && (64 * 8) % G == 0) ? nr - 1 - i : i) * G + c; if (L >= 64 * 8) return false;
        int pm, pn; pg8::tile_of((int)L, 64, 8, pm, pn, MK_WGM4); u.pm = pm; u.pn = pn; u.kind = K_OUT;
        u.A = (const char*)MG + (size_t)pm * (256 * 2048 * 2); u.B = (const char*)Wout_t + (size_t)pn * (256 * 2048 * 2);
        return true;
    }
    __device__ __forceinline__ bool epi(const f32x4 (&acc)[2][2][4][2], const pg8::Unit& u, int wr, int wc, int fr, int fq) const {
        bf16_t* base = OUTB + (size_t)(u.pm * 256 + wr * 64 + fr) * D + u.pn * 256 + wc * 32 + 8 * fq;
#pragma unroll
        for (int ai = 0; ai < 2; ++ai)
#pragma unroll
            for (int m = 0; m < 4; ++m)
#pragma unroll
                for (int bj = 0; bj < 2; ++bj) {
                    const f32x4 a = acc[ai][bj][m][0], b = acc[ai][bj][m][1];
                    u32x4 w; w.x = ST_PK(a[0], a[1]); w.y = ST_PK(a[2], a[3]); w.z = ST_PK(b[0], b[1]); w.w = ST_PK(b[2], b[3]);
                    *(u32x4*)(base + (size_t)(ai * 128 + m * 16) * D + bj * 128) = w;
                }
        return false;
    }
};

__device__ __forceinline__ unsigned f2bf(float f) { unsigned u = __builtin_bit_cast(unsigned, f); return (u + 0x7fffu + ((u >> 16) & 1u)) >> 16; }
__device__ __forceinline__ unsigned pk2(float lo, float hi) { return f2bf(lo) | (f2bf(hi) << 16); }
__device__ __forceinline__ int win_row(int n) {
    const int seg = n >> 11, ch = n & 2047, pr = ((ch >> 7) << 8) + (ch & 127);
    if (seg >= 3 && seg <= 6) {
        const int q = seg - 3, cu = ch & 63;
        return 6144 + 256 * (ch >> 6) + 128 * (q >> 1) + 32 * (cu >> 4) + 8 * ((cu >> 2) & 3) + 4 * (q & 1) + (cu & 3);
    }
    switch (seg) {
        case 0: return pr;            case 2: return pr + 128;
        case 1: return 4096 + ch;
        case 7: return 14336 + pr;    default: return 14336 + pr + 128;
    }
}
__device__ __forceinline__ unsigned pk4_i8(float a, float b, float c, float d) {
    const int q0 = (int)__builtin_rintf(a), q1 = (int)__builtin_rintf(b), q2 = (int)__builtin_rintf(c), q3 = (int)__builtin_rintf(d);
    return ((unsigned)q0 & 255u) | (((unsigned)q1 & 255u) << 8) | (((unsigned)q2 & 255u) << 16) | ((unsigned)q3 << 24);
}
template <bool MAP> __device__ __forceinline__ void p0_transpose_item(const float* W, int K, int N, bf16_t* WT, LAS float* scr, int kb, int nb, int lane) {
    const int k0 = 64 * kb, n0 = 32 * nb;
    float wv[32];
#pragma unroll
    for (int i = 0; i < 32; ++i) wv[i] = W[(size_t)(k0 + 2 * i + (lane >> 5)) * N + n0 + (lane & 31)];
#pragma unroll
    for (int i = 0; i < 32; ++i) scr[(2 * i + (lane >> 5)) * 33 + (lane & 31)] = wv[i];
    LDS_WAIT(); asm volatile("" ::: "memory");
    const int c = lane & 7;
#pragma unroll
    for (int j = 0; j < 4; ++j) { const int n = (lane >> 3) + 8 * j; const LAS float* s = scr + (8 * c) * 33 + n;
        const int rown = MAP ? win_row(n0 + n) : n0 + n;
        u32x4 o;
        if (MAP) { o.x = ST_PK(s[0 * 33], s[1 * 33]); o.y = ST_PK(s[2 * 33], s[3 * 33]); o.z = ST_PK(s[4 * 33], s[5 * 33]); o.w = ST_PK(s[6 * 33], s[7 * 33]); }
        else { o.x = OP_PK(s[0 * 33], s[1 * 33]); o.y = OP_PK(s[2 * 33], s[3 * 33]); o.z = OP_PK(s[4 * 33], s[5 * 33]); o.w = OP_PK(s[6 * 33], s[7 * 33]); }
        *(u32x4*)(WT + (size_t)rown * K + k0 + 8 * c) = o; }
    LDS_WAIT(); asm volatile("" ::: "memory");
}
constexpr int Q_KB = 68, Q_CP = 2180;
__device__ __forceinline__ void p0_quant_load(const Frame& F, int n0, int tid, f32x4 (&v)[16]) {
    const int c4 = tid & 3, r = tid >> 2;
    const float* wp = F.w_in + (size_t)r * NC + n0 + 4 * c4;
#pragma unroll
    for (int i = 0; i < 16; ++i) v[i] = *(const f32x4*)(wp + (size_t)(128 * i) * NC);
}
__device__ __forceinline__ void p0_quant_stage(const Frame& F, int tid, const f32x4 (&v)[16]) {
    LAS float* T = (LAS float*)F.lds;
    const int c4 = tid & 3, r = tid >> 2;
#pragma unroll
    for (int i = 0; i < 16; ++i) { const int k = r + 128 * i; LAS float* d = T + (4 * c4) * Q_CP + (k >> 6) * Q_KB + (k & 63);
        d[0] = v[i][0]; d[Q_CP] = v[i][1]; d[2 * Q_CP] = v[i][2]; d[3 * Q_CP] = v[i][3]; }
}
__device__ __forceinline__ void p0_quant_emit(const Frame& F, int n0, int tid) {
    const LAS float* T = (const LAS float*)F.lds;
    const int c = tid >> 5, kb = tid & 31;
    const LAS f32x4* src = (const LAS f32x4*)(T + c * Q_CP + kb * Q_KB);
    f32x4 v[16];
#pragma unroll
    for (int q = 0; q < 16; ++q) v[q] = src[q];
    f32x4 m4 = (f32x4){0.f, 0.f, 0.f, 0.f};
#pragma unroll
    for (int q = 0; q < 16; ++q) m4 = __builtin_elementwise_max(m4, __builtin_elementwise_abs(v[q]));
    float mx = fmaxf(fmaxf(m4[0], m4[1]), fmaxf(m4[2], m4[3]));
#pragma unroll
    for (int o = 1; o < 32; o <<= 1) mx = fmaxf(mx, __shfl_xor(mx, o));
    const float inv = mx > 0.f ? 127.f / mx : 0.f;
    const int row = win_row(n0 + c);
    if (kb == 0) F.SW[row] = mx > 0.f ? mx * (1.f / 127.f) : 1.f;
    unsigned d[16];
#pragma unroll
    for (int q = 0; q < 16; ++q) d[q] = pk4_i8(v[q][0] * inv, v[q][1] * inv, v[q][2] * inv, v[q][3] * inv);
    unsigned char* dst = F.Wi8 + (size_t)row * D + 64 * kb;
#pragma unroll
    for (int q = 0; q < 4; ++q) *(u32x4*)(dst + 16 * q) = (u32x4){d[4 * q], d[4 * q + 1], d[4 * q + 2], d[4 * q + 3]};
}
__device__ __forceinline__ void p0_xrow_emit(Frame& F, int row, int lane, const f32x4 (&v)[8]) {
    float mx = 0.f;
#pragma unroll
    for (int j = 0; j < 8; ++j) mx = fmaxf(fmaxf(mx, fmaxf(fabsf(v[j][0]), fabsf(v[j][1]))), fmaxf(fabsf(v[j][2]), fabsf(v[j][3])));
#pragma unroll
    for (int o = 1; o < 64; o <<= 1) mx = fmaxf(mx, __shfl_xor(mx, o));
    const float inv = mx > 0.f ? 127.f / mx : 0.f;
    if (lane == 0) F.SX[row] = mx > 0.f ? mx * (1.f / 127.f) : 1.f;
    unsigned char* xq = F.Xi8 + (size_t)row * D + 4 * lane;
#pragma unroll
    for (int j = 0; j < 8; ++j) *(unsigned*)(xq + 256 * j) = pk4_i8(v[j][0] * inv, v[j][1] * inv, v[j][2] * inv, v[j][3] * inv);
    if (MK_NBI < 32) {
        bf16_t* xb = F.Xb + (size_t)row * D + 4 * lane;
#pragma unroll
        for (int j = 0; j < 8; ++j) *(u32x2*)(xb + 256 * j) = (u32x2){ST_PK(v[j][0], v[j][1]), ST_PK(v[j][2], v[j][3])};
    }
}
__device__ __forceinline__ void p0_xrows(Frame& F, int gw, int NGW, int lane) {
    for (int row = gw; row < M; row += 2 * NGW) {
        const int row2 = row + NGW;
        const float* xp = F.x + (size_t)row * D + 4 * lane; const float* xp2 = F.x + (size_t)(row2 < M ? row2 : row) * D + 4 * lane;
        f32x4 v[8], w[8];
#pragma unroll
        for (int j = 0; j < 8; ++j) { v[j] = *(const f32x4*)(xp + 256 * j); w[j] = *(const f32x4*)(xp2 + 256 * j); }
        p0_xrow_emit(F, row, lane, v);
        if (row2 < M) p0_xrow_emit(F, row2, lane, w);
    }
}
constexpr int P0_ROWS_PER_QITEM = 16;
__device__ __forceinline__ void p0_xrows_range(Frame& F, int start, int nrows, int wave, int lane) {
    for (int k = wave; k < nrows; k += 16) {
        const int row = start + k, row2 = row + 8; const bool two = (k + 8) < nrows;
        const float* xp = F.x + (size_t)row * D + 4 * lane; const float* xp2 = F.x + (size_t)(two ? row2 : row) * D + 4 * lane;
        f32x4 v[8], w[8];
#pragma unroll
        for (int j = 0; j < 8; ++j) { v[j] = *(const f32x4*)(xp + 256 * j); w[j] = *(const f32x4*)(xp2 + 256 * j); }
        p0_xrow_emit(F, row, lane, v);
        if (two) p0_xrow_emit(F, row2, lane, w);
    }
}
template <int PART> __device__ __forceinline__ void p0_prologue(Frame& F) {
    constexpr int NCH16 = 4 * MK_NBI;
    constexpr int NQ = 384 + 4 * NCH16 + 256;
    auto grp = [&](int it0) -> int {
        const int it = MK_QPAIR ? (it0 & ~255) + 2 * (8 * (((it0 & 255) >> 3) >> 1) + (it0 & 7)) + (((it0 & 255) >> 3) & 1) : it0;
        if (it < 384) return it;
        if (it < 384 + 4 * NCH16) { const int q = it - 384; return 384 + (q / (NCH16 ? NCH16 : 1)) * 128 + q % (NCH16 ? NCH16 : 1); }
        return 896 + (it - 384 - 4 * NCH16); };
    if ((PART & 1) && F.bx < NQ) {
        f32x4 v[16];
        p0_quant_load(F, 16 * grp(F.bx), F.tid, v);
        for (int it = F.bx; it < NQ; it += F.G) {
            p0_quant_stage(F, F.tid, v);
            __syncthreads();
            if (it + F.G < NQ) p0_quant_load(F, 16 * grp(it + F.G), F.tid, v);
            p0_quant_emit(F, 16 * grp(it), F.tid);
            __syncthreads();
        }
    }
    LAS float* scr = (LAS float*)(F.lds + F.wave * 16384);
    const int gw = F.bx * 8 + F.wave, NGW = F.G * 8;
    constexpr int NB32 = 2 * (32 - MK_NBI);
    constexpr int I_BF = (D / 64) * 4 * NB32, I_SQ = (D / 64) * (D / 32);
    if (PART & 2) for (int it = gw; it < I_BF + 3 * I_SQ; it += NGW) {
        int r = it;
        if (r < I_BF) { const int kb = r / (4 * NB32), q = r % (4 * NB32), nb = 192 + (q / NB32) * 64 + 2 * MK_NBI + q % NB32;
            p0_transpose_item<true>(F.w_in, D, NC, F.Win_t - (size_t)6144 * D, scr, kb, nb, F.lane); continue; } r -= I_BF;
        if (r < I_SQ) { p0_transpose_item<false>(F.w_oa, D, D, F.Woa_t, scr, r / (D / 32), r % (D / 32), F.lane); continue; } r -= I_SQ;
        if (r < I_SQ) { p0_transpose_item<false>(F.w_ob, D, D, F.Wob_t, scr, r / (D / 32), r % (D / 32), F.lane); continue; } r -= I_SQ;
        p0_transpose_item<false>(F.w_out, D, D, F.Wout_t, scr, r / (D / 32), r % (D / 32), F.lane);
    }
    if (PART & 4) {
        const int rem = NQ % F.G, tot = M + P0_ROWS_PER_QITEM * rem;
        if (MK_P0BAL && rem != 0 && tot % F.G == 0 && tot / F.G > P0_ROWS_PER_QITEM) {
            const int hi = tot / F.G, lo = hi - P0_ROWS_PER_QITEM;
            const int start = F.bx < rem ? F.bx * lo : rem * lo + (F.bx - rem) * hi;
            p0_xrows_range(F, start, F.bx < rem ? lo : hi, F.wave, F.lane);
        } else p0_xrows(F, gw, NGW, F.lane);
    }
}

constexpr int P2_PITCH = 272;
constexpr int P2_BIMG = 0, P2_WIMG = 256 * P2_PITCH, P2_PART = P2_WIMG + 128 * P2_PITCH, P2_TAB = P2_PART + 16384;
__device__ __forceinline__ void p2_sgu(Frame& F) {
    LAS unsigned char* lds = F.lds;
    int tid = threadIdx.x; asm volatile("" : "+v"(tid));
    const int lane = tid & 63, w = __builtin_amdgcn_readfirstlane(tid >> 6), fr = lane & 15, fq = lane >> 4;
    const int rg = tid >> 4, ck = tid & 15;
    const unsigned gvoff = (unsigned)(rg * 128 + ck * 8) * 2u;
    const unsigned evoff = (unsigned)(fr * D + 32 * w + 8 * fq) * 2u;
    const unsigned wvoff = (unsigned)(rg * 128 + ck * 8) * 4u;
    int hprev = -1;
    u32x4 gvr[8];
    const int p2G = MK_P2HALF ? F.G / 2 : F.G, p2b = (MK_P2HALF && F.bx >= p2G) ? 1024 : F.bx;
    if (p2b < 1024) {
        unsigned gvo = gvoff; asm volatile("" : "+v"(gvo));
        const char* gbase = (const char*)F.GVt + (size_t)((p2b >> 3) * 8 + (p2b & 7)) * 65536;
#pragma unroll
        for (int i = 0; i < 8; ++i) gvr[i] = *(const u32x4*)(gbase + (size_t)i * (32 * 128 * 2) + gvo);
    }
    for (int it = p2b; it < 1024; it += p2G) {
        const int h = it & 7, c = it >> 3;
        unsigned gvo = gvoff, evo = evoff, wvo = wvoff;
        asm volatile("" : "+v"(gvo), "+v"(evo), "+v"(wvo));
        const char* ebase = (const char*)F.EW + ((size_t)(c * 128) * D + h * 256) * 2;
        char* ybase = (char*)F.YA + ((size_t)(c * 128) * D + h * 256) * 2;
        u32x4 ew[8];
#pragma unroll
        for (int m = 0; m < 8; ++m) ew[m] = *(const u32x4*)(ebase + (size_t)m * (16 * D * 2) + evo);
        LDS_BARRIER();
        if (h != hprev) {
            hprev = h;
            {
                LAS float* tab = (LAS float*)(lds + P2_TAB);
                if (tid < 256) { tab[tid] = F.ln_v_g[h * 256 + tid]; tab[256 + tid] = F.ln_v_b[h * 256 + tid]; }
                else if (tid < 384) tab[512 + (tid - 256)] = F.b_s[h * 128 + (tid - 256)];
            }
            const char* wbase = (const char*)F.w_s + (size_t)h * (128 * 128 * 4);
#pragma unroll
            for (int e = 0; e < 4; ++e) {
                const int t = rg + 32 * e;
                const f32x4 a = *(const f32x4*)(wbase + (size_t)e * (32 * 128 * 4) + wvo), b = *(const f32x4*)(wbase + (size_t)e * (32 * 128 * 4) + 16 + wvo);
                float v[8] = {a[0], a[1], a[2], a[3], b[0], b[1], b[2], b[3]};
#pragma unroll
                for (int j = 0; j < 8; ++j) v[j] = (ck * 8 + j <= t) ? v[j] : 0.f;
                u32x4 o; o.x = ST_PK(v[0], v[1]); o.y = ST_PK(v[2], v[3]); o.z = ST_PK(v[4], v[5]); o.w = ST_PK(v[6], v[7]);
                *(LAS u32x4*)(lds + P2_WIMG + (rg * P2_PITCH + (ck << 4)) + e * (32 * P2_PITCH)) = o;
            }
        }
        float sm[8], sq[8];
#pragma unroll
        for (int j = 0; j < 8; ++j) { sm[j] = 0.f; sq[j] = 0.f; }
#pragma unroll
        for (int i = 0; i < 8; ++i) {
            const unsigned ww[4] = {gvr[i].x, gvr[i].y, gvr[i].z, gvr[i].w};
#pragma unroll
            for (int p = 0; p < 4; ++p) { const float lo = ST_LO(ww[p]), hi = ST_HI(ww[p]); sm[2 * p] += lo; sq[2 * p] += lo * lo; sm[2 * p + 1] += hi; sq[2 * p + 1] += hi * hi; }
        }
#pragma unroll
        for (int j = 0; j < 8; ++j) { sm[j] += __shfl_xor(sm[j], 16); sm[j] += __shfl_xor(sm[j], 32); sq[j] += __shfl_xor(sq[j], 16); sq[j] += __shfl_xor(sq[j], 32); }
        if (lane < 16) {
            LAS f32x4* pp = (LAS f32x4*)(lds + P2_PART + (w * 128 + ck * 8) * 8);
#pragma unroll
            for (int j = 0; j < 4; ++j) pp[j] = (f32x4){sm[2 * j], sq[2 * j], sm[2 * j + 1], sq[2 * j + 1]};
        }
        LDS_BARRIER();
        if (tid < 128) {
            float s1 = 0.f, s2 = 0.f;
#pragma unroll
            for (int ww = 0; ww < 8; ++ww) { const f32x2 v = *(const LAS f32x2*)(lds + P2_PART + tid * 8 + ww * (128 * 8)); s1 += v.x; s2 += v.y; }
            const float mean = s1 * (1.f / 256.f), var = s2 * (1.f / 256.f) - mean * mean;
            *(LAS f32x2*)(lds + P2_PART + 8192 + tid * 8) = (f32x2){mean, rsqrtf(fmaxf(var, 0.f) + LN_EPS)};
        }
        LDS_BARRIER();
        float mu[8], rs[8];
        {
            const LAS f32x4* pp = (const LAS f32x4*)(lds + P2_PART + 8192 + (ck * 8) * 8);
#pragma unroll
            for (int j = 0; j < 4; ++j) { const f32x4 v = pp[j]; mu[2 * j] = v[0]; rs[2 * j] = v[1]; mu[2 * j + 1] = v[2]; rs[2 * j + 1] = v[3]; }
        }
        float nmr[8];
#pragma unroll
        for (int j = 0; j < 8; ++j) nmr[j] = -mu[j] * rs[j];
#pragma unroll
        for (int i = 0; i < 8; ++i) {
            const float g = ((const LAS float*)(lds + P2_TAB))[rg + 32 * i], b = ((const LAS float*)(lds + P2_TAB))[256 + rg + 32 * i];
            const unsigned ww[4] = {gvr[i].x, gvr[i].y, gvr[i].z, gvr[i].w};
            float v[8];
#pragma unroll
            for (int p = 0; p < 4; ++p) { v[2 * p] = fmaf(fmaf(ST_LO(ww[p]), rs[2 * p], nmr[2 * p]), g, b); v[2 * p + 1] = fmaf(fmaf(ST_HI(ww[p]), rs[2 * p + 1], nmr[2 * p + 1]), g, b); }
            u32x4 o; o.x = ST_PK(v[0], v[1]); o.y = ST_PK(v[2], v[3]); o.z = ST_PK(v[4], v[5]); o.w = ST_PK(v[6], v[7]);
            *(LAS u32x4*)(lds + P2_BIMG + (rg * P2_PITCH + (ck << 4)) + i * (32 * P2_PITCH)) = o;
        }
        __builtin_amdgcn_sched_barrier(0);
        {
            const int it2 = it + p2G;
            if (it2 < 1024) {
                const char* gbase2 = (const char*)F.GVt + (size_t)((it2 >> 3) * 8 + (it2 & 7)) * 65536;
#pragma unroll
                for (int i = 0; i < 8; ++i) gvr[i] = *(const u32x4*)(gbase2 + (size_t)i * (32 * 128 * 2) + gvo);
            }
        }
        LDS_BARRIER();
        bf16x8 Bf[2][4];
        const int brow = 32 * w + 8 * (fr >> 2) + (fr & 3);
        const LAS unsigned char* bptr = lds + P2_BIMG + brow * P2_PITCH + (fq << 4);
        const LAS unsigned char* wptr = lds + P2_WIMG + fr * P2_PITCH + (fq << 4);
#pragma unroll
        for (int itl = 0; itl < 2; ++itl)
#pragma unroll
            for (int kk = 0; kk < 4; ++kk) Bf[itl][kk] = *(const LAS bf16x8*)(bptr + itl * (4 * P2_PITCH) + kk * 64);
        f32x4 acc[8][2];
#pragma unroll
        for (int m = 0; m < 8; ++m) { const float bs = ((const LAS float*)(lds + P2_TAB))[512 + fr + 16 * m]; acc[m][0] = (f32x4){bs, bs, bs, bs}; acc[m][1] = (f32x4){bs, bs, bs, bs}; }
#pragma unroll
        for (int m = 0; m < 8; ++m) {
            __builtin_amdgcn_sched_barrier(0);
#pragma unroll
            for (int kk = 0; kk < 4; ++kk) {
                if (kk <= (m >> 1)) {
                    const bf16x8 wf = *(const LAS bf16x8*)(wptr + m * (16 * P2_PITCH) + kk * 64);
                    acc[m][0] = MFMA_16(Bf[0][kk], wf, acc[m][0]);
                    acc[m][1] = MFMA_16(Bf[1][kk], wf, acc[m][1]);
                }
            }
        }
        __builtin_amdgcn_sched_barrier(0);
#pragma unroll
        for (int m = 0; m < 8; ++m) {
            const float bs = 0.f;
            const u32x4 e = ew[m];
            u32x4 o;
            o.x = OP_PK(ST_LO(e.x) * (acc[m][0][0] + bs), ST_HI(e.x) * (acc[m][0][1] + bs));
            o.y = OP_PK(ST_LO(e.y) * (acc[m][0][2] + bs), ST_HI(e.y) * (acc[m][0][3] + bs));
            o.z = OP_PK(ST_LO(e.z) * (acc[m][1][0] + bs), ST_HI(e.z) * (acc[m][1][1] + bs));
            o.w = OP_PK(ST_LO(e.w) * (acc[m][1][2] + bs), ST_HI(e.w) * (acc[m][1][3] + bs));
            *(u32x4*)(ybase + (size_t)m * (16 * D * 2) + evo) = o;
        }
    }
    __syncthreads();
}
__device__ __forceinline__ void p2_fix(Frame& F) {
    int tid = threadIdx.x; asm volatile("" : "+v"(tid));
    const int r = tid >> 8, ch = (tid & 255) * 8;
    const bf16_t* HALO = F.FIX; const bf16_t* H01 = F.FIX + 64 * 2 * D; const bf16_t* G01 = F.FIX + 2 * 64 * 2 * D;
    for (int pm = F.bx; pm < 64; pm += F.G) {
        const bool first = (pm & 31) == 0;
        const u32x4 z4 = (u32x4){0u, 0u, 0u, 0u};
        const u32x4 hA = first ? z4 : *(const u32x4*)(HALO + ((size_t)(pm - 1) * 2 + 0) * D + ch);
        const u32x4 hB = first ? z4 : *(const u32x4*)(HALO + ((size_t)(pm - 1) * 2 + 1) * D + ch);
        const u32x4 h00 = *(const u32x4*)(H01 + ((size_t)pm * 2 + 0) * D + ch), h01 = *(const u32x4*)(H01 + ((size_t)pm * 2 + 1) * D + ch);
        const u32x4 gv = *(const u32x4*)(G01 + ((size_t)pm * 2 + r) * D + ch);
        const u32x4 v0 = r == 0 ? h00 : h01, v1 = r == 0 ? hB : h00, v2 = r == 0 ? hA : hB;
        const unsigned a0[4] = {v0.x, v0.y, v0.z, v0.w}, a1[4] = {v1.x, v1.y, v1.z, v1.w}, a2[4] = {v2.x, v2.y, v2.z, v2.w}, ag[4] = {gv.x, gv.y, gv.z, gv.w};
        unsigned o[4];
#pragma unroll
        for (int p = 0; p < 4; ++p) {
            const int c0 = ch + 2 * p;
            const float y0 = ST_LO(ag[p]) * (F.conv_b[c0] + F.conv_w[c0] * ST_LO(a2[p]) + F.conv_w[D + c0] * ST_LO(a1[p]) + F.conv_w[2 * D + c0] * ST_LO(a0[p]));
            const float y1 = ST_HI(ag[p]) * (F.conv_b[c0 + 1] + F.conv_w[c0 + 1] * ST_HI(a2[p]) + F.conv_w[D + c0 + 1] * ST_HI(a1[p]) + F.conv_w[2 * D + c0 + 1] * ST_HI(a0[p]));
            o[p] = OP_PK(y0, y1);
        }
        *(u32x4*)(F.YB + (size_t)(pm * 256 + r) * D + ch) = (u32x4){o[0], o[1], o[2], o[3]};
    }
}

__device__ __forceinline__ void p5_ln(Frame& F) {
    int tid = threadIdx.x; asm volatile("" : "+v"(tid));
    const int lane = tid & 63, gw = F.bx * 8 + __builtin_amdgcn_readfirstlane(tid >> 6), NGW = F.G * 8;
    f32x4 g[8], b[8];
#pragma unroll
    for (int j = 0; j < 8; ++j) { g[j] = *(const f32x4*)(F.ln_g + 4 * lane + 256 * j); b[j] = *(const f32x4*)(F.ln_b + 4 * lane + 256 * j); }
    for (int row = gw; row < M; row += NGW) {
        const float* xp = F.x + (size_t)row * D + 4 * lane; const bf16_t* op = F.OUTB + (size_t)row * D + 4 * lane; float* rp = F.out + (size_t)row * D + 4 * lane;
        f32x4 v[8]; u32x2 o[8];
#if MK_F16S && MK_NBI < 32 && MK_P5XH
        {
            const bf16_t* hp = F.Xb + (size_t)row * D + 4 * lane; u32x2 xh[8];
#pragma unroll
            for (int j = 0; j < 8; ++j) { xh[j] = *(const u32x2*)(hp + 256 * j); o[j] = *(const u32x2*)(op + 256 * j); }
#pragma unroll
            for (int j = 0; j < 8; ++j) v[j] = (f32x4){ST_LO(xh[j].x), ST_HI(xh[j].x), ST_LO(xh[j].y), ST_HI(xh[j].y)};
        }
        (void)xp;
#else
#pragma unroll
        for (int j = 0; j < 8; ++j) { v[j] = *(const f32x4*)(xp + 256 * j); o[j] = *(const u32x2*)(op + 256 * j); }
#endif
        float s = 0.f;
#pragma unroll
        for (int j = 0; j < 8; ++j) { v[j] = v[j] * DN_ALPHA + (f32x4){ST_LO(o[j].x), ST_HI(o[j].x), ST_LO(o[j].y), ST_HI(o[j].y)}; s += (v[j][0] + v[j][1]) + (v[j][2] + v[j][3]); }
#pragma unroll
        for (int of = 1; of < 64; of <<= 1) s += __shfl_xor(s, of);
        const float mean = s * (1.f / D); float q = 0.f;
#pragma unroll
        for (int j = 0; j < 8; ++j) { v[j] = v[j] - mean; q += (v[j][0] * v[j][0] + v[j][1] * v[j][1]) + (v[j][2] * v[j][2] + v[j][3] * v[j][3]); }
#pragma unroll
        for (int of = 1; of < 64; of <<= 1) q += __shfl_xor(q, of);
        const float rstd = rsqrtf(q * (1.f / D) + LN_EPS);
#pragma unroll
        for (int j = 0; j < 8; ++j) *(f32x4*)(rp + 256 * j) = v[j] * rstd * g[j] + b[j];
    }
}

struct Args { const float* in[14]; float* out; unsigned char* ws; int ph_lo, ph_hi; };
__global__ void __launch_bounds__(512, 2) mk_fwd(Args args) {
    extern __shared__ __attribute__((aligned(16))) unsigned char lds_raw[];
    Frame F;
    F.lds = (LAS unsigned char*)lds_raw;
    F.tid = threadIdx.x; F.lane = F.tid & 63; F.wave = __builtin_amdgcn_readfirstlane(F.tid >> 6); F.G = gridDim.x; F.bx = blockIdx.x;
    unsigned char* ws = args.ws;
    F.x = args.in[0]; F.w_in = args.in[1]; F.b_gate = args.in[2]; F.ln_v_g = args.in[3]; F.ln_v_b = args.in[4]; F.w_s = args.in[5]; F.b_s = args.in[6];
    F.conv_w = args.in[7]; F.conv_b = args.in[8]; F.w_oa = args.in[9]; F.w_ob = args.in[10]; F.w_out = args.in[11]; F.ln_g = args.in[12]; F.ln_b = args.in[13];
    F.out = args.out;
    F.Woa_t = (bf16_t*)(ws + WS_WOA); F.Wob_t = (bf16_t*)(ws + WS_WOB); F.Wout_t = (bf16_t*)(ws + WS_WOUT);
    F.Xb = (bf16_t*)(ws + WS_XB); F.EW = (bf16_t*)(ws + WS_EW); F.GVt = (bf16_t*)(ws + WS_GVT); F.FIX = (bf16_t*)(ws + WS_FIX);
    F.RT = (bf16_t*)(ws + WS_RT); F.GBb = (bf16_t*)(ws + WS_GB); F.YA = (bf16_t*)(ws + WS_YA); F.YB = (bf16_t*)(ws + WS_YB); F.MG = (bf16_t*)(ws + WS_MG);
    F.OUTB = (bf16_t*)(ws + WS_OUTB); F.Wi8 = ws + WS_WI8; F.Win_t = (bf16_t*)(ws + WS_WBF); F.Xi8 = ws + WS_XQ; F.SX = (float*)(ws + WS_SX); F.SW = (float*)(ws + WS_SW);
    for (int u = F.tid; u < (LDS_BYTES - LDSCTL_OFF) / 4; u += 512) ((LAS unsigned*)(F.lds + LDSCTL_OFF))[u] = 0u;
    __syncthreads();
    const int lo = args.ph_lo, hi = args.ph_hi;
    XcdBarrier bar; bar.bar = (unsigned*)(ws + WS_CTL); bar.x = 0; bar.st = nullptr;
    if (hi - lo > 1) bar = xcd_barrier_post((unsigned*)(ws + WS_CTL), (volatile LAS unsigned*)(F.lds + MISC_OFF));
#ifndef PH_MASK
#define PH_MASK 63
#endif
#define IN(k) (((PH_MASK >> (k)) & 1) && lo <= (k) && (k) < hi)
#define GRID_BAR(k) do { if (IN(k) && IN((k) + 1)) xcd_barrier(bar); } while (0)
#ifndef MK_DOUBLE
#define MK_DOUBLE -1
#endif
    if (IN(0)) { p0_prologue<7>(F); if (MK_DOUBLE == 0) { __syncthreads(); p0_prologue<7>(F); } if (MK_DOUBLE == 11) { __syncthreads(); p0_prologue<1>(F); } if (MK_DOUBLE == 12) { __syncthreads(); p0_prologue<2>(F); } if (MK_DOUBLE == 13) { __syncthreads(); p0_prologue<4>(F); } }
    GRID_BAR(0);
    if (IN(1)) { ProgP1 P{F.Xi8, F.Wi8, F.SX, F.SW, F.EW, F.GVt, F.YB, F.FIX, F.RT, F.GBb, F.b_gate, F.conv_w, F.conv_b, F.lds + HL_OFF, F.G, F.bx, (void*)(ws + WS_CTL + 49152)}; pg8::gemm_phase(F.lds, P); if (MK_DOUBLE == 1) pg8::gemm_phase(F.lds, P);
                 if (MK_NBI < 32) { ProgP1B PB{F.Xb, F.Win_t, F.YB, F.FIX, F.conv_w, F.conv_b, F.lds + HL_OFF, F.G, F.bx}; pg8::gemm_phase(F.lds, PB); if (MK_DOUBLE == 8) pg8::gemm_phase(F.lds, PB); }
                 if (MK_DOUBLE == 14) { ProgP4 P4{F.Xb, F.Wout_t, (bf16_t*)F.out, F.G, F.bx}; pg8::gemm_phase(F.lds, P4); } }
    GRID_BAR(1);
    if (IN(2)) { p2_fix(F); p2_sgu(F); if (MK_DOUBLE == 2) { p2_fix(F); p2_sgu(F); } }
    GRID_BAR(2);
    if (IN(3)) { ProgP3 P{F.YA, F.YB, F.Woa_t, F.Wob_t, F.RT, F.GBb, F.MG, F.G, F.bx}; pg8::gemm_phase(F.lds, P); if (MK_DOUBLE == 3) pg8::gemm_phase(F.lds, P); }
    GRID_BAR(3);
    if (IN(4)) { ProgP4 P{F.MG, F.Wout_t, F.OUTB, F.G, F.bx}; pg8::gemm_phase(F.lds, P); if (MK_DOUBLE == 4) pg8::gemm_phase(F.lds, P); }
    GRID_BAR(4);
    if (IN(5)) { p5_ln(F); if (MK_DOUBLE == 7) p5_ln(F); }
    if (MK_DOUBLE == 15) { ProgP1B PB{F.Xb, F.Win_t, F.YB, F.FIX, F.conv_w, F.conv_b, F.lds + HL_OFF, F.G, F.bx}; pg8::gemm_phase(F.lds, PB); }
    if (MK_DOUBLE == 17) { ProgP4 P4{F.MG, F.Wout_t, F.YB, F.G, F.bx}; pg8::gemm_phase(F.lds, P4); }
    if (MK_DOUBLE == 18) { ProgP4 P4{F.YB, F.Wout_t, F.MG, F.G, F.bx}; pg8::gemm_phase(F.lds, P4); }
    if (MK_DOUBLE == 19) { ProgP4 P4{F.MG, F.Wout_t, F.OUTB, F.G, F.bx}; pg8::gemm_phase(F.lds, P4); }
    if (MK_DOUBLE == 16) { ProgP4 P4{F.Xb, F.Wout_t, F.MG, F.G, F.bx}; pg8::gemm_phase(F.lds, P4); }
#undef IN
#undef GRID_BAR
}


extern "C" void kernel_launch(void* const* d_in, const int* in_sizes, int n_in, void* d_out, int out_size, void* d_ws, size_t ws_size, hipStream_t stream) {
    static int grid = 0;
    if (grid == 0) {
        if (n_in != 14 || in_sizes[0] != M * D || out_size != M * D || ws_size < WS_END) {
            fprintf(stderr, "kernel_launch: unexpected shapes: n_in %d in0 %d out %d ws %zu (need %zu)\n", n_in, n_in > 0 ? in_sizes[0] : -1, out_size, ws_size, (size_t)WS_END); grid = -1; return; }
        int dev = 0, cus = 0, per_cu = 0;
        if (hipGetDevice(&dev) != hipSuccess || hipDeviceGetAttribute(&cus, hipDeviceAttributeMultiprocessorCount, dev) != hipSuccess) { grid = -1; return; }
        if (hipFuncSetAttribute((const void*)mk_fwd, hipFuncAttributeMaxDynamicSharedMemorySize, LDS_BYTES) != hipSuccess) { fprintf(stderr, "kernel_launch: hipFuncSetAttribute failed\n"); grid = -1; return; }
        if (hipOccupancyMaxActiveBlocksPerMultiprocessor(&per_cu, (const void*)mk_fwd, 512, LDS_BYTES) != hipSuccess || per_cu < 1) {
            fprintf(stderr, "kernel_launch: occupancy query says %d blocks per CU; cannot run the persistent grid\n", per_cu); (void)hipGetLastError(); grid = -1; return; }
        grid = cus;
        if (grid % 8 != 0) fprintf(stderr, "kernel_launch: note: grid %d is not a multiple of 8\n", grid);
    }
    if (grid < 0) return;
    (void)hipMemsetAsync((char*)d_ws + WS_CTL, 0, CTL_ZERO_BYTES, stream);
    Args a{};
    for (int i = 0; i < 14; ++i) a.in[i] = (const float*)d_in[i];
    a.out = (float*)d_out; a.ws = (unsigned char*)d_ws;
    if (MK_N_LAUNCHES == 1) {
        a.ph_lo = 0; a.ph_hi = NPH;
        hipLaunchKernelGGL(mk_fwd, dim3(grid), dim3(512), LDS_BYTES, stream, a);
    } else {
        for (int p = 0; p < NPH; ++p) { a.ph_lo = p; a.ph_hi = p + 1; hipLaunchKernelGGL(mk_fwd, dim3(grid), dim3(512), LDS_BYTES, stream, a); }
    }
    const hipError_t le = hipPeekAtLastError();
    if (le != hipSuccess) fprintf(stderr, "kernel_launch: launch failed: %s\n", hipGetErrorName(le));
}
```

```cpp
#include <hip/hip_runtime.h>
#include <cstdio>
#include <cstdint>

#ifndef MK_SP2
#define MK_SP2 1
#endif
#ifndef MK_ALIGN
#define MK_ALIGN 1
#endif
#ifndef MK_SYNC_K
#define MK_SYNC_K 0
#endif
#ifndef MK_EPI2
#define MK_EPI2 0
#endif
#ifndef MK_WGM1
#define MK_WGM1 4
#endif
#ifndef MK_WGM1B
#define MK_WGM1B 4
#endif
#ifndef MK_WGM3
#define MK_WGM3 4
#endif
#ifndef MK_WGM4
#define MK_WGM4 4
#endif
#ifndef MK_KS2_DIV
#define MK_KS2_DIV 1
#endif
#ifndef MK_KS2_MOD
#define MK_KS2_MOD 1
#endif
#ifndef MK_KS2_MUL
#define MK_KS2_MUL 0
#endif
#ifndef MK_PNROT
#define MK_PNROT 1
#endif
#ifndef MK_NT1
#define MK_NT1 0
#endif
#ifndef MK_NT1B
#define MK_NT1B 0
#endif
#ifndef MK_NT3
#define MK_NT3 0
#endif
#ifndef MK_NT4
#define MK_NT4 0
#endif
#ifndef MK_QPAIR
#define MK_QPAIR 1
#endif
#ifndef MK_F16S
#define MK_F16S 1
#endif
#ifndef MK_NTST
#define MK_NTST 0
#endif
#ifndef MK_P5XH
#define MK_P5XH 1
#endif
#ifndef MK_F16M
#define MK_F16M 0
#endif
#ifndef MK_P0BAL
#define MK_P0BAL 1
#endif
#ifndef MK_P4REV
#define MK_P4REV 0
#endif
#ifndef MK_P2HALF
#define MK_P2HALF 0
#endif
#ifndef MK_PF
#define MK_PF 0
#endif
#ifndef MK_KSTAG
#define MK_KSTAG 1
#endif
#ifndef MK_NBI
#define MK_NBI 28
#endif
#ifndef MK_N_LAUNCHES
#define MK_N_LAUNCHES 1
#endif

#define LAS __attribute__((address_space(3)))
#define GAS __attribute__((address_space(1)))
typedef unsigned short bf16_t;
typedef short bf16x8 __attribute__((ext_vector_type(8)));
typedef float f32x4 __attribute__((ext_vector_type(4)));
typedef float f32x2 __attribute__((ext_vector_type(2)));
typedef unsigned u32x4 __attribute__((ext_vector_type(4)));
typedef unsigned u32x2 __attribute__((ext_vector_type(2)));

constexpr int M = 16384, D = 2048, NC = 18432, SEQ = 8192;
constexpr float LN_EPS = 1e-5f;
constexpr float DN_ALPHA = 1.189207115002721f;
constexpr int NPH = 6;

constexpr size_t MiB = 1u << 20;
constexpr size_t WS_CTL = 0, CTL_ZERO_BYTES = 64 * 1024;
constexpr size_t WS_WOA = 1 * MiB, WS_WOB = 9 * MiB, WS_WOUT = 17 * MiB;
constexpr size_t WS_WI8 = 25 * MiB;
constexpr size_t WS_WBF = 61 * MiB;
constexpr size_t WS_XB = 93 * MiB;
constexpr size_t WS_XQ = 157 * MiB;
constexpr size_t WS_EW = 189 * MiB, WS_GVT = 253 * MiB, WS_YB = 317 * MiB;
constexpr size_t WS_FIX = 381 * MiB;
constexpr size_t WS_SX = 383 * MiB, WS_SW = 384 * MiB;
constexpr size_t WS_RT = 441 * MiB, WS_GB = 505 * MiB;
constexpr size_t WS_YA = 25 * MiB;
constexpr size_t WS_MG = 189 * MiB;
constexpr size_t WS_OUTB = 253 * MiB;
constexpr size_t WS_END = 569 * MiB;

constexpr int RING_BYTES = 131072;
constexpr int LDSCTL_OFF = 163840 - 512, MISC_OFF = LDSCTL_OFF + 320;
constexpr int LDS_BYTES = 163840;
constexpr int HL_OFF = RING_BYTES, HL_PITCH = 136;

typedef __bf16 bf16x2_t __attribute__((ext_vector_type(2)));
__device__ __forceinline__ unsigned cvt_pk_bf16(float lo, float hi) { const bf16x2_t v = __builtin_convertvector((f32x2){lo, hi}, bf16x2_t); return __builtin_bit_cast(unsigned, v); }
typedef _Float16 f16x2_t __attribute__((ext_vector_type(2)));
__device__ __forceinline__ unsigned cvt_pk_f16(float lo, float hi) { const f16x2_t v = __builtin_convertvector((f32x2){lo, hi}, f16x2_t); return __builtin_bit_cast(unsigned, v); }
__device__ __forceinline__ f32x2 h2f(unsigned w) { return __builtin_convertvector(__builtin_bit_cast(f16x2_t, w), f32x2); }
typedef _Float16 f16x8 __attribute__((ext_vector_type(8)));
#define MFMA_F16(a, b, c) __builtin_amdgcn_mfma_f32_16x16x32_f16(__builtin_bit_cast(f16x8, a), __builtin_bit_cast(f16x8, b), c, 0, 0, 0)
#define MFMA_BF16(a, b, c) __builtin_amdgcn_mfma_f32_16x16x32_bf16(a, b, c, 0, 0, 0)
#if MK_F16M
#define OP_PK(lo, hi) cvt_pk_f16(lo, hi)
#else
#define OP_PK(lo, hi) cvt_pk_bf16(lo, hi)
#endif
#if MK_F16S
#define MFMA_16(a, b, c) __builtin_amdgcn_mfma_f32_16x16x32_f16(__builtin_bit_cast(f16x8, a), __builtin_bit_cast(f16x8, b), c, 0, 0, 0)
#else
#define MFMA_16(a, b, c) __builtin_amdgcn_mfma_f32_16x16x32_bf16(a, b, c, 0, 0, 0)
#endif
#if MK_F16S
#define ST_PK(lo, hi) cvt_pk_f16(lo, hi)
#define ST_LO(w) (h2f(w).x)
#define ST_HI(w) (h2f(w).y)
#else
#define ST_PK(lo, hi) cvt_pk_bf16(lo, hi)
#define ST_LO(w) bf_lo(w)
#define ST_HI(w) bf_hi(w)
#endif
#if MK_NTST
#define NT_ST(p, v) __builtin_nontemporal_store((v), (p))
#else
#define NT_ST(p, v) (*(p) = (v))
#endif
__device__ __forceinline__ float bf_lo(unsigned w) { return __builtin_bit_cast(float, w << 16); }
__device__ __forceinline__ float bf_hi(unsigned w) { return __builtin_bit_cast(float, w & 0xffff0000u); }
__device__ __forceinline__ float ex2(float x) { return __builtin_amdgcn_exp2f(x); }
__device__ __forceinline__ float rcp(float x) { return __builtin_amdgcn_rcpf(x); }
constexpr float LOG2E = 1.4426950408889634f;
constexpr float GELU_C1 = -(float)(1.5957691216057308 * 1.4426950408889634);
constexpr float GELU_C3 = -(float)(1.5957691216057308 * 1.4426950408889634 * 0.044715);
__device__ __forceinline__ float gelu_den(float x) { return 1.0f + ex2(x * (GELU_C1 + GELU_C3 * x * x)); }
__device__ __forceinline__ float sig_den(float x) { return 1.0f + ex2(-LOG2E * x); }

#define VM_WAIT() asm volatile("s_waitcnt vmcnt(0)" ::: "memory")
#define LDS_BARRIER() asm volatile("s_waitcnt lgkmcnt(0)\n\ts_barrier" ::: "memory")
#define LDS_WAIT() asm volatile("s_waitcnt lgkmcnt(0)" ::: "memory")

#define XB_TMO      128
#define XB_XCNT(j)  (256  + 64 * (j))
#define XB_XSUB(j)  (1280 + 64 * (j))
#define XB_XGEN(j)  (2304 + 64 * (j))
#define XB_TOP      3328
#define XB_TOPGEN   3392
#define XCD_BAR_WORDS 3456
#define XB_SPIN_CAP (1u << 18)
__device__ __forceinline__ unsigned xb_ld(unsigned* p)              { return __hip_atomic_load(p, __ATOMIC_RELAXED, __HIP_MEMORY_SCOPE_AGENT); }
__device__ __forceinline__ unsigned xb_add(unsigned* p, unsigned v) { return __hip_atomic_fetch_add(p, v, __ATOMIC_RELAXED, __HIP_MEMORY_SCOPE_AGENT); }
__device__ __forceinline__ unsigned xb_xcc_id() { return (unsigned)__builtin_amdgcn_s_getreg((3 << 11) | 20) & 0xFu; }
#define XB_SPIN(cond, bar) do { unsigned _sp = 0; while (cond) { __builtin_amdgcn_s_sleep(1); \
    if ((++_sp & 255u) == 0u) { if (xb_ld(&(bar)[XB_TMO])) break; if (_sp > XB_SPIN_CAP) { atomicAdd(&(bar)[XB_TMO], 1u); break; } } } } while (0)
struct XcdBarrier { unsigned* bar; unsigned x; volatile LAS unsigned* st; };
__device__ __forceinline__ XcdBarrier xcd_barrier_post(unsigned* bar, volatile LAS unsigned* st) {
    XcdBarrier b; b.bar = bar; b.x = xb_xcc_id(); b.st = st;
    if (threadIdx.x == 0) (void)xb_add(&bar[XB_XCNT(b.x)], 1u);
    return b;
}
__device__ __forceinline__ void xcd_barrier_complete(unsigned* bar, unsigned x, unsigned& nloc, unsigned& nx) {
    const unsigned G = gridDim.x * gridDim.y * gridDim.z;
    unsigned sum, cnt, mine, sp = 0u;
    for (;;) {
        sum = 0u; cnt = 0u; mine = 0u;
#pragma unroll
        for (unsigned j = 0; j < 16; ++j) { const unsigned c = xb_ld(&bar[XB_XCNT(j)]); sum += c; cnt += (c > 0u) ? 1u : 0u; mine = (j == x) ? c : mine; }
        if (sum == G) break;
        __builtin_amdgcn_s_sleep(1);
        if ((++sp & 255u) == 0u) { if (xb_ld(&bar[XB_TMO])) break; if (sp > XB_SPIN_CAP) { atomicAdd(&bar[XB_TMO], 1u); break; } }
    }
    nloc = mine > 0u ? mine : 1u; nx = cnt > 0u ? cnt : 1u;
}
__device__ __forceinline__ void xcd_barrier(const XcdBarrier& b) {
    asm volatile("s_waitcnt vmcnt(0)" ::: "memory");
    __syncthreads();
    if (threadIdx.x == 0) {
        unsigned* bar = b.bar;
        __builtin_amdgcn_s_waitcnt(0);
        unsigned nloc = b.st[0], nx = b.st[1];
        if (nloc == 0u) { xcd_barrier_complete(bar, b.x, nloc, nx); b.st[0] = nloc; b.st[1] = nx; }
        const unsigned old = xb_add(&bar[XB_XSUB(b.x)], 1u);
        const unsigned gen = old / nloc;
        if (old + 1u == (gen + 1u) * nloc) {
            __builtin_amdgcn_fence(__ATOMIC_RELEASE, "agent");
            asm volatile("s_waitcnt vmcnt(0)" ::: "memory");
            const unsigned og = xb_add(&bar[XB_TOP], 1u);
            const unsigned tg = og / nx;
            if (og + 1u == (tg + 1u) * nx) xb_add(&bar[XB_TOPGEN], 1u);
            else XB_SPIN(xb_ld(&bar[XB_TOPGEN]) == tg, bar);
            __builtin_amdgcn_fence(__ATOMIC_ACQUIRE, "agent");
            xb_add(&bar[XB_XGEN(b.x)], 1u);
            asm volatile("s_waitcnt vmcnt(0)" ::: "memory");
        } else {
            XB_SPIN(xb_ld(&bar[XB_XGEN(b.x)]) == gen, bar);
            __builtin_amdgcn_fence(__ATOMIC_ACQUIRE, "agent");
            asm volatile("s_waitcnt vmcnt(0)" ::: "memory");
        }
    }
    __syncthreads();
}

namespace pg8 {
constexpr int PF_OFF = LDSCTL_OFF - 8192;
constexpr int BM = 256, BK = 64, HALF = 128, HTB = HALF * BK * 2, STAGE_BYTES = 8 * HTB, NXCD = 8, KD = 2048;
__device__ __forceinline__ int lds_byte(int r, int c) { const int st = (r >> 4) * 2 + (c >> 5), rr = r & 15, cc = c & 31, ob = rr * 64 + cc * 2; return st * 1024 + (ob ^ (((ob >> 9) & 1) << 5)); }
__device__ __forceinline__ void stage_rc(int b, int& R, int& C) { const int st = b / 1024, sb = b % 1024, swz = sb ^ (((sb >> 9) & 1) << 5); R = (st >> 1) * 16 + swz / 64; C = (st & 1) * 32 + (swz % 64) / 2; }
__device__ __forceinline__ int perm32(int rho) { const int n = rho >> 4, i = rho & 15; return 8 * (i >> 2) + 4 * n + (i & 3); }

struct Unit { const char* A; const char* B; int kind, pm, pn; };
typedef int i32x8 __attribute__((ext_vector_type(8)));
typedef int i32x4v __attribute__((ext_vector_type(4)));
template <bool F8, bool I8> struct FragSel { typedef bf16x8 type; };
template <> struct FragSel<true, false> { typedef i32x8 type; };
template <> struct FragSel<false, true> { typedef i32x4v type; };
template <bool I8> struct AccSel { typedef f32x4 type; };
template <> struct AccSel<true> { typedef i32x4v type; };

__device__ __forceinline__ void tile_of(int L, int nM, int nN, int& pm, int& pn, const int WGM = 8) {
    const int nwg = nM * nN; int wgid = L;
    { const int q = nwg / NXCD, r = nwg % NXCD, xcd = wgid % NXCD, off = wgid / NXCD; wgid = (xcd < r ? xcd * (q + 1) : r * (q + 1) + (xcd - r) * q) + off; }
    const int nig = WGM * nN, gid = wgid / nig, fm = gid * WGM, gsz = (nM - fm) < WGM ? (nM - fm) : WGM;
    pm = fm + ((wgid % nig) % gsz); pn = (wgid % nig) / gsz;
}

template <class Prog>
__device__ __forceinline__ void gemm_phase(LAS unsigned char* lds, const Prog& P) {
    int tid = threadIdx.x; asm volatile("" : "+v"(tid));
    const int wid = __builtin_amdgcn_readfirstlane(tid >> 6), lane = tid & 63, wr = wid >> 2, wc = wid & 3, fr = lane & 15, fq = lane >> 4;
    constexpr bool FP8 = Prog::FP8;
    constexpr bool I8 = Prog::I8;
    constexpr int PB = (FP8 || I8) ? KD : 2 * KD, nt = (FP8 || I8) ? KD / 128 : KD / BK;
    using FragT = typename FragSel<FP8, I8>::type; using AccT = typename AccSel<I8>::type; constexpr int NF = FP8 ? 1 : 2;
    unsigned voffA[2], voffB[2];
#pragma unroll
    for (int i = 0; i < 2; ++i) { int R, C; stage_rc(tid * 16 + i * 8192, R, C); const int Rb = (R & ~31) + perm32(R & 31);
        voffA[i] = (unsigned)(R * PB + C * 2); voffB[i] = (unsigned)(Rb * PB + C * 2); }
    const size_t kstep = (size_t)(BK * 2);
    const size_t hstep = (size_t)HALF * PB;
    const unsigned ldsw = (unsigned)wid * 1024u;
    const int aoff = lds_byte(wr * 64 + fr, fq * 8), boff = lds_byte(wc * 32 + fr, fq * 8);
#define PG8_SA(b, h) (((b) * 2 + (h)) * HTB)
#define PG8_SB(b, h) ((4 + (b) * 2 + (h)) * HTB)
#define PG8_STAGE(bufoff, gbase, voff) do { _Pragma("unroll") for (int _i = 0; _i < 2; ++_i) { \
        if ((bufoff) < 4 * HTB) __builtin_amdgcn_global_load_lds((const unsigned*)((const char*)(gbase) + (voff)[_i]), (LAS unsigned*)(lds + (bufoff) + ldsw + _i * 8192), 16, 0, Prog::NT_A); \
        else __builtin_amdgcn_global_load_lds((const unsigned*)((const char*)(gbase) + (voff)[_i]), (LAS unsigned*)(lds + (bufoff) + ldsw + _i * 8192), 16, 0, Prog::NT_B); } } while (0)
#define PG8_LDA(dst, b, h) do { _Pragma("unroll") for (int m = 0; m < 4; ++m) { \
        if constexpr (FP8) { dst[m][0].lo = *(const LAS i32x4v*)(lds + PG8_SA(b, h) + aoff + m * 2048); dst[m][0].hi = *(const LAS i32x4v*)(lds + PG8_SA(b, h) + aoff + m * 2048 + 1024); } \
        else { _Pragma("unroll") for (int k = 0; k < 2; ++k) dst[m][k] = *(const LAS FragT*)(lds + PG8_SA(b, h) + aoff + m * 2048 + k * 1024); } } } while (0)
#define PG8_LDB(dst, b, h) do { _Pragma("unroll") for (int n = 0; n < 2; ++n) { \
        if constexpr (FP8) { dst[n][0].lo = *(const LAS i32x4v*)(lds + PG8_SB(b, h) + boff + n * 2048); dst[n][0].hi = *(const LAS i32x4v*)(lds + PG8_SB(b, h) + boff + n * 2048 + 1024); } \
        else { _Pragma("unroll") for (int k = 0; k < 2; ++k) dst[n][k] = *(const LAS FragT*)(lds + PG8_SB(b, h) + boff + n * 2048 + k * 1024); } } } while (0)
#define PG8_MMA(ai, bj, At, Bt) do { __builtin_amdgcn_s_setprio(1); _Pragma("unroll") for (int m = 0; m < 4; ++m) _Pragma("unroll") for (int n = 0; n < 2; ++n) { \
        if constexpr (FP8) asm volatile("v_mfma_scale_f32_16x16x128_f8f6f4 %0, %1, %2, %0, %3, %4 op_sel_hi:[0,0,0]" : "+v"(acc[ai][bj][m][n]) : "v"(Bt[n][0]), "v"(At[m][0]), "v"(scl_b), "v"(scl_a));   \
        else if constexpr (I8) { _Pragma("unroll") for (int k = 0; k < 2; ++k) acc[ai][bj][m][n] = __builtin_amdgcn_mfma_i32_16x16x64_i8(Bt[n][k], At[m][k], acc[ai][bj][m][n], 0, 0, 0); } \
        else { _Pragma("unroll") for (int k = 0; k < 2; ++k) acc[ai][bj][m][n] = (Prog::F16 ? MFMA_F16(Bt[n][k], At[m][k], acc[ai][bj][m][n]) : MFMA_BF16(Bt[n][k], At[m][k], acc[ai][bj][m][n])); } } \
        __builtin_amdgcn_s_setprio(0); } while (0)
#define PG8_WAIT_V(n) asm volatile("s_waitcnt vmcnt(" #n ")" ::: "memory")
#define PG8_WAIT_L(n) asm volatile("s_waitcnt lgkmcnt(" #n ")" ::: "memory")
#define PG8_BAR __builtin_amdgcn_s_barrier()
#define PG8_SCHED __builtin_amdgcn_sched_barrier(0)
    Unit cur, nxt; int ui = 0;
    if (!P.next(0, cur)) return;
    AccT acc[2][2][4][2];
#pragma unroll
    for (int a = 0; a < 2; ++a)
#pragma unroll
        for (int b = 0; b < 2; ++b)
#pragma unroll
            for (int m = 0; m < 4; ++m)
#pragma unroll
                for (int n = 0; n < 2; ++n) acc[a][b][m][n] = (AccT){0, 0, 0, 0};
    FragT At[4][NF], B0[2][NF], B1[2][NF];
    const int scl_a = Prog::SCALE_A, scl_b = Prog::SCALE_B; (void)scl_a; (void)scl_b;
    const char* cA = cur.A; const char* cB = cur.B;
    const int k0s = MK_KSTAG ? ((int)(blockIdx.x % NXCD) * 2 * MK_KSTAG + (((int)(blockIdx.x / NXCD) / MK_KS2_DIV) % MK_KS2_MOD) * MK_KS2_MUL) * (nt / 16) : 0;
#define PG8_KO(t) ((size_t)(((t) + k0s) & (nt - 1)) * kstep)
#if MK_SP2
    PG8_STAGE(PG8_SB(0, 0), cB + PG8_KO(0), voffB); PG8_STAGE(PG8_SB(0, 1), cB + PG8_KO(0) + hstep, voffB); PG8_STAGE(PG8_SA(0, 0), cA + PG8_KO(0), voffA); PG8_STAGE(PG8_SA(0, 1), cA + PG8_KO(0) + hstep, voffA);
    if (wr == 1) PG8_BAR;
    PG8_WAIT_V(2); PG8_BAR;
    PG8_STAGE(PG8_SB(1, 0), cB + PG8_KO(1), voffB); PG8_STAGE(PG8_SA(1, 0), cA + PG8_KO(1), voffA); PG8_STAGE(PG8_SB(1, 1), cB + hstep + PG8_KO(1), voffB);
    PG8_WAIT_V(6); PG8_BAR;
#else
    PG8_STAGE(PG8_SB(0, 0), cB, voffB); PG8_STAGE(PG8_SA(0, 0), cA, voffA); PG8_STAGE(PG8_SB(0, 1), cB + hstep, voffB); PG8_STAGE(PG8_SA(0, 1), cA + hstep, voffA);
    if (wr == 1) PG8_BAR;
    PG8_WAIT_V(4); PG8_BAR;
    PG8_STAGE(PG8_SB(1, 0), cB + kstep, voffB); PG8_STAGE(PG8_SA(1, 0), cA + kstep, voffA); PG8_STAGE(PG8_SB(1, 1), cB + hstep + kstep, voffB);
    PG8_WAIT_V(6); PG8_BAR;
#endif
    for (;;) {
        const bool has_next = P.next(ui + 1, nxt);
        const char* nA = has_next ? nxt.A : cA; const char* nB = has_next ? nxt.B : cB;
        for (int t = 0; t < nt; t += 2) {
            const bool last = (t == nt - 2);
            if constexpr (MK_PF && Prog::PF) { if (t == nt - 4) P.prefetch(cur, tid, lds + PF_OFF + ldsw / 2); }
            const char* a1 = cA + PG8_KO(t + 1);
            const char* a2 = (last ? nA : cA) + PG8_KO(t + 2); const char* b2 = (last ? nB : cB) + PG8_KO(t + 2);
            const char* a3 = (last ? nA : cA) + PG8_KO(t + 3); const char* b3 = (last ? nB : cB) + PG8_KO(t + 3);
#if MK_SP2
            PG8_LDB(B0, 0, 0); PG8_LDB(B1, 0, 1); PG8_SCHED; PG8_LDA(At, 0, 0); PG8_STAGE(PG8_SA(1, 1), a1 + hstep, voffA);
            PG8_WAIT_V(8); PG8_WAIT_L(0); PG8_BAR; PG8_MMA(0, 0, At, B0); PG8_MMA(0, 1, At, B1); PG8_BAR; PG8_SCHED;
            PG8_LDA(At, 0, 1); PG8_STAGE(PG8_SB(0, 0), b2, voffB); PG8_STAGE(PG8_SB(0, 1), b2 + hstep, voffB); PG8_STAGE(PG8_SA(0, 0), a2, voffA);
            PG8_WAIT_V(8); PG8_WAIT_L(0); PG8_BAR; PG8_MMA(1, 0, At, B0); PG8_MMA(1, 1, At, B1); PG8_BAR; PG8_SCHED;
            PG8_LDB(B0, 1, 0); PG8_LDB(B1, 1, 1); PG8_SCHED; PG8_LDA(At, 1, 0); PG8_STAGE(PG8_SA(0, 1), a2 + hstep, voffA);
            PG8_WAIT_V(8); PG8_WAIT_L(0); PG8_BAR; PG8_MMA(0, 0, At, B0); PG8_MMA(0, 1, At, B1); PG8_BAR; PG8_SCHED;
            PG8_LDA(At, 1, 1); PG8_STAGE(PG8_SB(1, 0), b3, voffB); PG8_STAGE(PG8_SB(1, 1), b3 + hstep, voffB); PG8_STAGE(PG8_SA(1, 0), a3, voffA);
            PG8_WAIT_V(8); PG8_WAIT_L(0); PG8_BAR; PG8_MMA(1, 0, At, B0); PG8_MMA(1, 1, At, B1); PG8_BAR; PG8_SCHED;
#else
            PG8_LDB(B0, 0, 0); PG8_SCHED; PG8_LDA(At, 0, 0); PG8_STAGE(PG8_SA(1, 1), a1 + hstep, voffA);
            PG8_WAIT_L(8); PG8_BAR; PG8_WAIT_L(0); PG8_MMA(0, 0, At, B0); PG8_BAR; PG8_SCHED;
            PG8_LDB(B1, 0, 1); PG8_STAGE(PG8_SB(0, 0), b2, voffB);
            PG8_BAR; PG8_WAIT_L(0); PG8_MMA(0, 1, At, B1); PG8_BAR;
            PG8_LDA(At, 0, 1); PG8_STAGE(PG8_SA(0, 0), a2, voffA);
            PG8_BAR; PG8_WAIT_L(0); PG8_MMA(1, 0, At, B0); PG8_BAR; PG8_SCHED;
            PG8_STAGE(PG8_SB(0, 1), b2 + hstep, voffB);
            PG8_WAIT_V(6); PG8_BAR; PG8_MMA(1, 1, At, B1); PG8_BAR;
            PG8_LDB(B0, 1, 0); PG8_SCHED; PG8_LDA(At, 1, 0); PG8_STAGE(PG8_SA(0, 1), a2 + hstep, voffA);
            PG8_WAIT_L(8); PG8_BAR; PG8_WAIT_L(0); PG8_MMA(0, 0, At, B0); PG8_BAR; PG8_SCHED;
            PG8_LDB(B1, 1, 1); PG8_STAGE(PG8_SB(1, 0), b3, voffB);
            PG8_BAR; PG8_WAIT_L(0); PG8_MMA(0, 1, At, B1); PG8_BAR;
            PG8_LDA(At, 1, 1); PG8_STAGE(PG8_SA(1, 0), a3, voffA);
            PG8_BAR; PG8_WAIT_L(0); PG8_MMA(1, 0, At, B0); PG8_BAR; PG8_SCHED;
            PG8_STAGE(PG8_SB(1, 1), b3 + hstep, voffB);
            PG8_WAIT_V(6); PG8_BAR; PG8_MMA(1, 1, At, B1); PG8_BAR;
#endif
        }
#if MK_ALIGN
        if (wr == 0) PG8_BAR;
#endif
        if constexpr (FP8) asm volatile("s_nop 15\n\ts_nop 15" ::: "memory");
        int z_e = 0; asm volatile("" : "+v"(z_e));
        const int lane_e = (int)__builtin_amdgcn_mbcnt_hi(~0u, __builtin_amdgcn_mbcnt_lo(~0u, (unsigned)z_e)), fr_e = lane_e & 15, fq_e = lane_e >> 4;
#if MK_EPI2
        if (Prog::EPI2) (void)P.epi(acc, cur, wr, wc, fr_e, fq_e);
#endif
        const bool keep = P.epi(acc, cur, wr, wc, fr_e, fq_e);
        if (!has_next) break;
        if (!keep) {
#pragma unroll
            for (int a = 0; a < 2; ++a)
#pragma unroll
                for (int b = 0; b < 2; ++b)
#pragma unroll
                    for (int m = 0; m < 4; ++m)
#pragma unroll
                        for (int n = 0; n < 2; ++n) acc[a][b][m][n] = (AccT){0, 0, 0, 0};
        }
        cur = nxt; cA = nA; cB = nB; ++ui;
#if MK_ALIGN
        if (wr == 1) PG8_BAR;
#endif
    }
    PG8_WAIT_V(0);
#if !MK_ALIGN
    if (wr == 0) PG8_BAR;
#endif
    PG8_BAR;
#undef PG8_SA
#undef PG8_SB
#undef PG8_STAGE
#undef PG8_LDA
#undef PG8_LDB
#undef PG8_MMA
#undef PG8_WAIT_V
#undef PG8_WAIT_L
#undef PG8_BAR
#undef PG8_SCHED
}
}

struct Frame {
    LAS unsigned char* lds;
    int tid, lane, wave, G, bx;
    const float *x, *w_in, *b_gate, *ln_v_g, *ln_v_b, *w_s, *b_s, *conv_w, *conv_b, *w_oa, *w_ob, *w_out, *ln_g, *ln_b;
    float* out;
    bf16_t *Win_t, *Woa_t, *Wob_t, *Wout_t, *Xb, *EW, *GVt, *FIX, *RT, *GBb, *YA, *YB, *MG, *OUTB;
    unsigned char *Wi8, *Xi8; float *SX, *SW;
};

__host__ __device__ __forceinline__ size_t gvt_index(int ch, int t) { return ((((size_t)(t >> 7) * 8 + (ch >> 8)) * 256 + (ch & 255)) << 7) + (t & 127); }

enum { K_EW = 0, K_GVT = 1, K_BU = 2, K_GATE = 4, K_MIDA = 5, K_MRG = 6, K_OUT = 7 };
struct ProgP1 {
    static constexpr bool EPI2 = true, FP8 = false, I8 = true; static constexpr int NT_A = (MK_NT1) & 3, NT_B = ((MK_NT1) >> 2) & 3; static constexpr bool F16 = false; static constexpr bool PF = true;
    static constexpr int SCALE_A = 0, SCALE_B = 0;
    const unsigned char *Xi8, *Wi8; const float *SX, *SW; bf16_t *EW, *GVt, *YB, *FIX, *RT, *GBb; const float *b_gate, *conv_w, *conv_b; LAS unsigned char* hl; int G, c; void* dbg;
    typedef pg8::i32x4v ivec;
    static __device__ __forceinline__ f32x2 ex2v(f32x2 x) { return (f32x2){ex2(x.x), ex2(x.y)}; }
    static __device__ __forceinline__ f32x2 rcpv(f32x2 x) { return (f32x2){rcp(x.x), rcp(x.y)}; }
    static __device__ __forceinline__ f32x2 sig_den2(f32x2 x) { return ex2v(x * (-LOG2E)) + 1.0f; }
    static __device__ __forceinline__ f32x2 gelu_den2(f32x2 x) { return ex2v(x * (x * x * GELU_C3 + GELU_C1)) + 1.0f; }
    static __device__ __forceinline__ f32x4 tof(ivec v) { return (f32x4){(float)v[0], (float)v[1], (float)v[2], (float)v[3]}; }
    __device__ __forceinline__ void prefetch(const pg8::Unit& u, int tid, LAS unsigned char* dump) const {
        if (tid < 64) {
            const int j = tid & 7, g = (tid >> 3) & 3;
            const float* q = g == 0 ? SX + u.pm * 256 + j * 32 : g == 1 ? SW + u.pn * 256 + j * 32 : b_gate + (j >> 2) * D + ((u.pn >= 56 ? u.pn - 56 : 0) * 128) + (j & 3) * 32;
            __builtin_amdgcn_global_load_lds((const unsigned*)q, (LAS unsigned*)dump, 4, 0, 0);
        }
    }
    __device__ __forceinline__ bool next(int i, pg8::Unit& u) const {
        constexpr int NPN = 40 + MK_NBI;
        const long L = (long)i * G + c; if (L >= 64 * NPN) return false;
        int pm, pn; pg8::tile_of((int)L, 64, NPN, pm, pn, MK_WGM1);
        if (MK_PNROT) pn = (pn + (c % 8) * (NPN / 8)) % NPN;
        pn = pn < 16 ? pn + 56 : pn - 16;
        u.pm = pm; u.pn = pn;
        const char* xp = (const char*)Xi8 + (size_t)pm * (256 * 2048); const char* wp = (const char*)Wi8 + (size_t)pn * (256 * 2048);
        if (pn < 16) { u.kind = K_EW; u.A = xp; u.B = wp; }
        else if (pn < 24) { u.kind = K_GVT; u.A = wp; u.B = xp; }
        else if (pn < 56) { u.kind = K_BU; u.A = xp; u.B = wp; }
        else { u.kind = K_GATE; u.A = xp; u.B = wp; }
        return true;
    }
    __device__ __forceinline__ bool epi(const ivec (&acc)[2][2][4][2], const pg8::Unit& u, int wr, int wc, int fr, int fq) const {
        const int rloc = wr * 64 + fr, cloc = wc * 32 + 8 * fq;
        const int kind = u.kind;
        if (kind == K_GVT) {
            bf16_t* base = GVt + ((((size_t)(2 * u.pm) * 8 + (u.pn - 16)) * 256 + rloc) << 7) + cloc;
            f32x4 sxc[2][2];
#pragma unroll
            for (int bj = 0; bj < 2; ++bj)
#pragma unroll
                for (int n = 0; n < 2; ++n) sxc[bj][n] = *(const f32x4*)(SX + u.pm * 256 + bj * 128 + cloc + 4 * n);
            const float* swp = SW + u.pn * 256 + rloc;
#pragma unroll
            for (int ai = 0; ai < 2; ++ai)
#pragma unroll
                for (int m = 0; m < 4; ++m) {
                    const float swr = swp[ai * 128 + m * 16];
#pragma unroll
                    for (int bj = 0; bj < 2; ++bj) {
                        const f32x4 a = tof(acc[ai][bj][m][0]) * sxc[bj][0] * swr, b = tof(acc[ai][bj][m][1]) * sxc[bj][1] * swr;
                        const f32x2 a01 = (f32x2){a[0], a[1]}, a23 = (f32x2){a[2], a[3]}, b01 = (f32x2){b[0], b[1]}, b23 = (f32x2){b[2], b[3]};
                        const f32x2 r0 = a01 * rcpv(gelu_den2(a01)), r1 = a23 * rcpv(gelu_den2(a23)), r2 = b01 * rcpv(gelu_den2(b01)), r3 = b23 * rcpv(gelu_den2(b23));
                        u32x4 w; w.x = ST_PK(r0.x, r0.y); w.y = ST_PK(r1.x, r1.y); w.z = ST_PK(r2.x, r2.y); w.w = ST_PK(r3.x, r3.y);
                        NT_ST((u32x4*)(base + (size_t)bj * (8 * 256 * 128) + (size_t)(ai * 128 + m * 16) * 128), (w));
                    }
                }
            return false;
        }
        f32x4 sw[2][2];
#pragma unroll
        for (int bj = 0; bj < 2; ++bj)
#pragma unroll
            for (int n = 0; n < 2; ++n) sw[bj][n] = *(const f32x4*)(SW + u.pn * 256 + bj * 128 + cloc + 4 * n);
        const float* sxp = SX + u.pm * 256 + rloc;
        if (kind == K_GATE) {
            const int ch = (u.pn - 56) * 128 + cloc;
            f32x4 ba[2], bb[2];
#pragma unroll
            for (int n = 0; n < 2; ++n) { ba[n] = *(const f32x4*)(b_gate + ch + 4 * n); bb[n] = *(const f32x4*)(b_gate + D + ch + 4 * n); }
            const size_t o0 = (size_t)(u.pm * 256 + rloc) * D + ch;
#pragma unroll
            for (int ai = 0; ai < 2; ++ai)
#pragma unroll
                for (int m = 0; m < 4; ++m) {
                    const float sxr = sxp[ai * 128 + m * 16];
                    unsigned w1[4], w2[4];
#pragma unroll
                    for (int n = 0; n < 2; ++n) {
                        const f32x4 va = tof(acc[ai][0][m][n]) * (sw[0][n] * sxr) + ba[n], vb = tof(acc[ai][1][m][n]) * (sw[1][n] * sxr) + bb[n];
#pragma unroll
                        for (int jj = 0; jj < 2; ++jj) {
                            f32x2 xa = (f32x2){va[2 * jj], va[2 * jj + 1]}, xb = (f32x2){vb[2 * jj], vb[2 * jj + 1]};
                            xa.x = fminf(fmaxf(xa.x, -30.f), 30.f); xa.y = fminf(fmaxf(xa.y, -30.f), 30.f); xb.x = fminf(fmaxf(xb.x, -30.f), 30.f); xb.y = fminf(fmaxf(xb.y, -30.f), 30.f);
                            const f32x2 da = sig_den2(xa), db = sig_den2(xb);
                            const f32x2 rt = db * rcpv(da), gb = rcpv(db);
                            w1[2 * n + jj] = cvt_pk_bf16(rt.x, rt.y); w2[2 * n + jj] = cvt_pk_bf16(gb.x, gb.y);
                        }
                    }
                    const size_t o = o0 + (size_t)(ai * 128 + m * 16) * D;
                    NT_ST((u32x4*)(RT + o), ((u32x4){w1[0], w1[1], w1[2], w1[3]})); NT_ST((u32x4*)(GBb + o), ((u32x4){w2[0], w2[1], w2[2], w2[3]}));
                }
            return false;
        }
        if (kind == K_EW) {
            bf16_t* base = EW + (size_t)(u.pm * 256 + rloc) * D + u.pn * 128 + cloc;
#pragma unroll
            for (int ai = 0; ai < 2; ++ai)
#pragma unroll
                for (int m = 0; m < 4; ++m) {
                    const float sxr = sxp[ai * 128 + m * 16];
                    unsigned w[4];
#pragma unroll
                    for (int n = 0; n < 2; ++n) {
                        const f32x4 va = tof(acc[ai][0][m][n]) * (sw[0][n] * sxr), vb = tof(acc[ai][1][m][n]) * (sw[1][n] * sxr);
#pragma unroll
                        for (int jj = 0; jj < 2; ++jj) {
                            const f32x2 a = (f32x2){va[2 * jj], va[2 * jj + 1]}, b = (f32x2){vb[2 * jj], vb[2 * jj + 1]};
                            const f32x2 r = a * b * rcpv(gelu_den2(a) * sig_den2(b));
                            w[2 * n + jj] = ST_PK(r.x, r.y);
                        }
                    }
                    NT_ST((u32x4*)(base + (size_t)(ai * 128 + m * 16) * D), ((u32x4){w[0], w[1], w[2], w[3]}));
                }
            return false;
        }
        epi_bu(acc, u, sw, sxp, wr, wc, fr, fq);
        return false;
    }
    __device__ __forceinline__ void epi_bu(const ivec (&acc)[2][2][4][2], const pg8::Unit& u, const f32x4 (&sw)[2][2], const float* sxp, int wr, int wc, int fr, int fq) const {
        const int ub = u.pn - 24, cu = 16 * wc + 4 * fq, ch = 64 * ub + cu;
        const f32x4 w0 = *(const f32x4*)(conv_w + ch), w1 = *(const f32x4*)(conv_w + D + ch), w2 = *(const f32x4*)(conv_w + 2 * D + ch), cb = *(const f32x4*)(conv_b + ch);
        bf16_t* HALO = FIX; bf16_t* H01 = FIX + 64 * 2 * D; bf16_t* G01 = FIX + 2 * 64 * 2 * D;
        LAS unsigned char* hrow = hl + (64 * wr + fr) * HL_PITCH + cu * 2;
#pragma unroll
        for (int ai = 0; ai < 2; ++ai) {
            u32x2 hw[4]; f32x4 gg[4];
#pragma unroll
            for (int m = 0; m < 4; ++m) {
                const float sxr = sxp[ai * 128 + m * 16];
                const f32x4 x = tof(acc[ai][0][m][0]) * (sw[0][0] * sxr), c = tof(acc[ai][0][m][1]) * (sw[0][1] * sxr), b = tof(acc[ai][1][m][0]) * (sw[1][0] * sxr), z = tof(acc[ai][1][m][1]) * (sw[1][1] * sxr);
                const f32x4 h = x * c;
                hw[m] = (u32x2){ST_PK(h[0], h[1]), ST_PK(h[2], h[3])};
                const f32x2 d01 = sig_den2((f32x2){z[0], z[1]}), d23 = sig_den2((f32x2){z[2], z[3]});
                const f32x2 g01 = (f32x2){b[0], b[1]} * (f32x2){z[0], z[1]} * rcpv(d01), g23 = (f32x2){b[2], b[3]} * (f32x2){z[2], z[3]} * rcpv(d23);
                const u32x2 gw = (u32x2){ST_PK(g01.x, g01.y), ST_PK(g23.x, g23.y)};
                gg[m] = (f32x4){ST_LO(gw.x), ST_HI(gw.x), ST_LO(gw.y), ST_HI(gw.y)};
                *(LAS u32x2*)(hrow + (2 + 16 * m) * HL_PITCH) = hw[m];
                if (ai == 0 && wr == 0 && m == 0 && fr < 2) {
                    *(u32x2*)(H01 + ((size_t)u.pm * 2 + fr) * D + ch) = hw[m]; *(u32x2*)(G01 + ((size_t)u.pm * 2 + fr) * D + ch) = gw; }
                if (ai == 1 && wr == 1 && m == 3 && fr >= 14) *(u32x2*)(HALO + ((size_t)u.pm * 2 + (fr - 14)) * D + ch) = hw[m];
            }
            if (ai == 1 && wr == 1 && fr >= 14) {
                const float sxr = sxp[48];
                const f32x4 h = (tof(acc[0][0][3][0]) * (sw[0][0] * sxr)) * (tof(acc[0][0][3][1]) * (sw[0][1] * sxr));
                *(LAS u32x2*)(hl + (fr - 14) * HL_PITCH + cu * 2) = (u32x2){ST_PK(h[0], h[1]), ST_PK(h[2], h[3])};
            }
            LDS_BARRIER();
            bf16_t* yrow = YB + (size_t)(u.pm * 256 + ai * 128 + 64 * wr + fr) * D + ch;
#pragma unroll
            for (int m = 0; m < 4; ++m) {
                const u32x2 a1 = *(const LAS u32x2*)(hrow + (1 + 16 * m) * HL_PITCH), a2 = *(const LAS u32x2*)(hrow + (16 * m) * HL_PITCH);
                const f32x4 h0 = (f32x4){ST_LO(hw[m].x), ST_HI(hw[m].x), ST_LO(hw[m].y), ST_HI(hw[m].y)};
                const f32x4 h1 = (f32x4){ST_LO(a1.x), ST_HI(a1.x), ST_LO(a1.y), ST_HI(a1.y)}, h2 = (f32x4){ST_LO(a2.x), ST_HI(a2.x), ST_LO(a2.y), ST_HI(a2.y)};
                const f32x4 y = gg[m] * (cb + w0 * h2 + w1 * h1 + w2 * h0);
                NT_ST((u32x2*)(yrow + (size_t)(16 * m) * D), ((u32x2){OP_PK(y[0], y[1]), OP_PK(y[2], y[3])}));
            }
            LDS_BARRIER();
        }
    }
};

struct ProgP1B {
    static constexpr bool EPI2 = false, FP8 = false, I8 = false; static constexpr int SCALE_A = 0, SCALE_B = 0; static constexpr void* dbg = nullptr; static constexpr int NT_A = (MK_NT1B) & 3, NT_B = ((MK_NT1B) >> 2) & 3; static constexpr bool F16 = (MK_F16S != 0); static constexpr bool PF = false;
    const bf16_t *Xb, *Wbf; bf16_t *YB, *FIX; const float *conv_w, *conv_b; LAS unsigned char* hl; int G, c;
    static __device__ __forceinline__ f32x2 ex2v(f32x2 x) { return (f32x2){ex2(x.x), ex2(x.y)}; }
    static __device__ __forceinline__ f32x2 rcpv(f32x2 x) { return (f32x2){rcp(x.x), rcp(x.y)}; }
    static __device__ __forceinline__ f32x2 sig_den2(f32x2 x) { return ex2v(x * (-LOG2E)) + 1.0f; }
    __device__ __forceinline__ bool next(int i, pg8::Unit& u) const {
        constexpr int NB = 32 - MK_NBI;
        const long L = (long)i * G + c; if (L >= 64 * NB) return false;
        int pm, pn; pg8::tile_of((int)L, 64, NB, pm, pn, MK_WGM1B); if (MK_PNROT) pn = (pn + (c % 8) * (NB / 8)) % NB; u.pm = pm; u.pn = 24 + MK_NBI + pn; u.kind = K_BU;
        u.A = (const char*)Xb + (size_t)pm * (256 * 2048 * 2); u.B = (const char*)Wbf + (size_t)(MK_NBI + pn) * (256 * 2048 * 2);
        return true;
    }
    __device__ __forceinline__ bool epi(const f32x4 (&acc)[2][2][4][2], const pg8::Unit& u, int wr, int wc, int fr, int fq) const {
        const int ub = u.pn - 24, cu = 16 * wc + 4 * fq, ch = 64 * ub + cu;
        const f32x4 w0 = *(const f32x4*)(conv_w + ch), w1 = *(const f32x4*)(conv_w + D + ch), w2 = *(const f32x4*)(conv_w + 2 * D + ch), cb = *(const f32x4*)(conv_b + ch);
        bf16_t* HALO = FIX; bf16_t* H01 = FIX + 64 * 2 * D; bf16_t* G01 = FIX + 2 * 64 * 2 * D;
        LAS unsigned char* hrow = hl + (64 * wr + fr) * HL_PITCH + cu * 2;
#pragma unroll
        for (int ai = 0; ai < 2; ++ai) {
            u32x2 hw[4]; f32x4 gg[4];
#pragma unroll
            for (int m = 0; m < 4; ++m) {
                const f32x4 x = acc[ai][0][m][0], c = acc[ai][0][m][1], b = acc[ai][1][m][0], z = acc[ai][1][m][1];
                const f32x4 h = x * c;
                hw[m] = (u32x2){ST_PK(h[0], h[1]), ST_PK(h[2], h[3])};
                const f32x2 d01 = sig_den2((f32x2){z[0], z[1]}), d23 = sig_den2((f32x2){z[2], z[3]});
                const f32x2 g01 = (f32x2){b[0], b[1]} * (f32x2){z[0], z[1]} * rcpv(d01), g23 = (f32x2){b[2], b[3]} * (f32x2){z[2], z[3]} * rcpv(d23);
                const u32x2 gw = (u32x2){ST_PK(g01.x, g01.y), ST_PK(g23.x, g23.y)};
                gg[m] = (f32x4){ST_LO(gw.x), ST_HI(gw.x), ST_LO(gw.y), ST_HI(gw.y)};
                *(LAS u32x2*)(hrow + (2 + 16 * m) * HL_PITCH) = hw[m];
                if (ai == 0 && wr == 0 && m == 0 && fr < 2) { *(u32x2*)(H01 + ((size_t)u.pm * 2 + fr) * D + ch) = hw[m]; *(u32x2*)(G01 + ((size_t)u.pm * 2 + fr) * D + ch) = gw; }
                if (ai == 1 && wr == 1 && m == 3 && fr >= 14) *(u32x2*)(HALO + ((size_t)u.pm * 2 + (fr - 14)) * D + ch) = hw[m];
            }
            if (ai == 1 && wr == 1 && fr >= 14) {
                const f32x4 h = acc[0][0][3][0] * acc[0][0][3][1];
                *(LAS u32x2*)(hl + (fr - 14) * HL_PITCH + cu * 2) = (u32x2){ST_PK(h[0], h[1]), ST_PK(h[2], h[3])};
            }
            LDS_BARRIER();
            bf16_t* yrow = YB + (size_t)(u.pm * 256 + ai * 128 + 64 * wr + fr) * D + ch;
#pragma unroll
            for (int m = 0; m < 4; ++m) {
                const u32x2 a1 = *(const LAS u32x2*)(hrow + (1 + 16 * m) * HL_PITCH), a2 = *(const LAS u32x2*)(hrow + (16 * m) * HL_PITCH);
                const f32x4 h0 = (f32x4){ST_LO(hw[m].x), ST_HI(hw[m].x), ST_LO(hw[m].y), ST_HI(hw[m].y)};
                const f32x4 h1 = (f32x4){ST_LO(a1.x), ST_HI(a1.x), ST_LO(a1.y), ST_HI(a1.y)}, h2 = (f32x4){ST_LO(a2.x), ST_HI(a2.x), ST_LO(a2.y), ST_HI(a2.y)};
                const f32x4 y = gg[m] * (cb + w0 * h2 + w1 * h1 + w2 * h0);
                NT_ST((u32x2*)(yrow + (size_t)(16 * m) * D), ((u32x2){OP_PK(y[0], y[1]), OP_PK(y[2], y[3])}));
            }
            LDS_BARRIER();
        }
        return false;
    }
};

struct ProgP3 {
    static constexpr bool EPI2 = false, FP8 = false, I8 = false; static constexpr int SCALE_A = 0, SCALE_B = 0; static constexpr void* dbg = nullptr; static constexpr int NT_A = (MK_NT3) & 3, NT_B = ((MK_NT3) >> 2) & 3; static constexpr bool F16 = (MK_F16M != 0); static constexpr bool PF = true;
    const bf16_t *YA, *YB, *Woa_t, *Wob_t, *RT, *GBb; bf16_t* MG; int G, c;
    __device__ __forceinline__ void prefetch(const pg8::Unit& u, int tid, LAS unsigned char* dump) const {
        const char* b = (const char*)(u.kind == K_MIDA ? RT : GBb) + (size_t)(u.pm * 256) * (D * 2) + (size_t)u.pn * 512;
        __builtin_amdgcn_global_load_lds((const unsigned*)(b + (size_t)(tid >> 2) * (D * 2) + (tid & 3) * 128), (LAS unsigned*)dump, 4, 0, 0);
        __builtin_amdgcn_global_load_lds((const unsigned*)(b + (size_t)(128 + (tid >> 2)) * (D * 2) + (tid & 3) * 128), (LAS unsigned*)(dump + 256), 4, 0, 0);
    }
    __device__ __forceinline__ bool next(int i, pg8::Unit& u) const {
        const long L = (long)(i >> 1) * G + c; if (L >= 64 * 8) return false;
        int pm, pn; pg8::tile_of((int)L, 64, 8, pm, pn, MK_WGM3); u.pm = pm; u.pn = pn;
        const size_t ao = (size_t)pm * (256 * 2048 * 2), bo = (size_t)pn * (256 * 2048 * 2);
        if ((i & 1) == 0) { u.kind = K_MIDA; u.A = (const char*)YA + ao; u.B = (const char*)Woa_t + bo; }
        else { u.kind = K_MRG; u.A = (const char*)YB + ao; u.B = (const char*)Wob_t + bo; }
        return true;
    }
    __device__ __forceinline__ bool epi(f32x4 (&acc)[2][2][4][2], const pg8::Unit& u, int wr, int wc, int fr, int fq) const {
        const size_t o0 = (size_t)(u.pm * 256 + wr * 64 + fr) * D + u.pn * 256 + wc * 32 + 8 * fq;
        if (u.kind == K_MIDA) {
#pragma unroll
            for (int ai = 0; ai < 2; ++ai)
#pragma unroll
                for (int m = 0; m < 4; ++m)
#pragma unroll
                    for (int bj = 0; bj < 2; ++bj) {
                        const u32x4 r = *(const u32x4*)(RT + o0 + (size_t)(ai * 128 + m * 16) * D + bj * 128);
                        acc[ai][bj][m][0][0] *= bf_lo(r.x); acc[ai][bj][m][0][1] *= bf_hi(r.x); acc[ai][bj][m][0][2] *= bf_lo(r.y); acc[ai][bj][m][0][3] *= bf_hi(r.y);
                        acc[ai][bj][m][1][0] *= bf_lo(r.z); acc[ai][bj][m][1][1] *= bf_hi(r.z); acc[ai][bj][m][1][2] *= bf_lo(r.w); acc[ai][bj][m][1][3] *= bf_hi(r.w);
                    }
            return true;
        }
#pragma unroll
        for (int ai = 0; ai < 2; ++ai)
#pragma unroll
            for (int m = 0; m < 4; ++m)
#pragma unroll
                for (int bj = 0; bj < 2; ++bj) {
                    const size_t o = o0 + (size_t)(ai * 128 + m * 16) * D + bj * 128;
                    const u32x4 g = *(const u32x4*)(GBb + o);
                    const f32x4 a = acc[ai][bj][m][0], b = acc[ai][bj][m][1];
                    u32x4 w;
                    w.x = OP_PK(a[0] * bf_lo(g.x), a[1] * bf_hi(g.x)); w.y = OP_PK(a[2] * bf_lo(g.y), a[3] * bf_hi(g.y));
                    w.z = OP_PK(b[0] * bf_lo(g.z), b[1] * bf_hi(g.z)); w.w = OP_PK(b[2] * bf_lo(g.w), b[3] * bf_hi(g.w));
                    *(u32x4*)(MG + o) = w;
                }
        return false;
    }
};

struct ProgP4 {
    static constexpr bool EPI2 = false, FP8 = false, I8 = false; static constexpr int SCALE_A = 0, SCALE_B = 0; static constexpr void* dbg = nullptr; static constexpr int NT_A = (MK_NT4) & 3, NT_B = ((MK_NT4) >> 2) & 3; static constexpr bool F16 = (MK_F16M != 0); static constexpr bool PF = false;
    const bf16_t *MG, *Wout_t; bf16_t* OUTB; int G, c;
    __device__ __forceinline__ bool next(int i, pg8::Unit& u) const {
        const int nr = (64 * 8 + G - 1) / G;
        if (i >= nr) return false;
        const long L = (long)((MK_P4REV && (64 * 8) % G == 0) ? nr - 1 - i : i) * G + c; if (L >= 64 * 8) return false;
        int pm, pn; pg8::tile_of((int)L, 64, 8, pm, pn, MK_WGM4); u.pm = pm; u.pn = pn; u.kind = K_OUT;
        u.A = (const char*)MG + (size_t)pm * (256 * 2048 * 2); u.B = (const char*)Wout_t + (size_t)pn * (256 * 2048 * 2);
        return true;
    }
    __device__ __forceinline__ bool epi(const f32x4 (&acc)[2][2][4][2], const pg8::Unit& u, int wr, int wc, int fr, int fq) const {
        bf16_t* base = OUTB + (size_t)(u.pm * 256 + wr * 64 + fr) * D + u.pn * 256 + wc * 32 + 8 * fq;
#pragma unroll
        for (int ai = 0; ai < 2; ++ai)
#pragma unroll
            for (int m = 0; m < 4; ++m)
#pragma unroll
                for (int bj = 0; bj < 2; ++bj) {
                    const f32x4 a = acc[ai][bj][m][0], b = acc[ai][bj][m][1];
                    u32x4 w; w.x = ST_PK(a[0], a[1]); w.y = ST_PK(a[2], a[3]); w.z = ST_PK(b[0], b[1]); w.w = ST_PK(b[2], b[3]);
                    *(u32x4*)(base + (size_t)(ai * 128 + m * 16) * D + bj * 128) = w;
                }
        return false;
    }
};

__device__ __forceinline__ unsigned f2bf(float f) { unsigned u = __builtin_bit_cast(unsigned, f); return (u + 0x7fffu + ((u >> 16) & 1u)) >> 16; }
__device__ __forceinline__ unsigned pk2(float lo, float hi) { return f2bf(lo) | (f2bf(hi) << 16); }
__device__ __forceinline__ int win_row(int n) {
    const int seg = n >> 11, ch = n & 2047, pr = ((ch >> 7) << 8) + (ch & 127);
    if (seg >= 3 && seg <= 6) {
        const int q = seg - 3, cu = ch & 63;
        return 6144 + 256 * (ch >> 6) + 128 * (q >> 1) + 32 * (cu >> 4) + 8 * ((cu >> 2) & 3) + 4 * (q & 1) + (cu & 3);
    }
    switch (seg) {
        case 0: return pr;            case 2: return pr + 128;
        case 1: return 4096 + ch;
        case 7: return 14336 + pr;    default: return 14336 + pr + 128;
    }
}
__device__ __forceinline__ unsigned pk4_i8(float a, float b, float c, float d) {
    const int q0 = (int)__builtin_rintf(a), q1 = (int)__builtin_rintf(b), q2 = (int)__builtin_rintf(c), q3 = (int)__builtin_rintf(d);
    return ((unsigned)q0 & 255u) | (((unsigned)q1 & 255u) << 8) | (((unsigned)q2 & 255u) << 16) | ((unsigned)q3 << 24);
}
template <bool MAP> __device__ __forceinline__ void p0_transpose_item(const float* W, int K, int N, bf16_t* WT, LAS float* scr, int kb, int nb, int lane) {
    const int k0 = 64 * kb, n0 = 32 * nb;
    float wv[32];
#pragma unroll
    for (int i = 0; i < 32; ++i) wv[i] = W[(size_t)(k0 + 2 * i + (lane >> 5)) * N + n0 + (lane & 31)];
#pragma unroll
    for (int i = 0; i < 32; ++i) scr[(2 * i + (lane >> 5)) * 33 + (lane & 31)] = wv[i];
    LDS_WAIT(); asm volatile("" ::: "memory");
    const int c = lane & 7;
#pragma unroll
    for (int j = 0; j < 4; ++j) { const int n = (lane >> 3) + 8 * j; const LAS float* s = scr + (8 * c) * 33 + n;
        const int rown = MAP ? win_row(n0 + n) : n0 + n;
        u32x4 o;
        if (MAP) { o.x = ST_PK(s[0 * 33], s[1 * 33]); o.y = ST_PK(s[2 * 33], s[3 * 33]); o.z = ST_PK(s[4 * 33], s[5 * 33]); o.w = ST_PK(s[6 * 33], s[7 * 33]); }
        else { o.x = OP_PK(s[0 * 33], s[1 * 33]); o.y = OP_PK(s[2 * 33], s[3 * 33]); o.z = OP_PK(s[4 * 33], s[5 * 33]); o.w = OP_PK(s[6 * 33], s[7 * 33]); }
        *(u32x4*)(WT + (size_t)rown * K + k0 + 8 * c) = o; }
    LDS_WAIT(); asm volatile("" ::: "memory");
}
constexpr int Q_KB = 68, Q_CP = 2180;
__device__ __forceinline__ void p0_quant_load(const Frame& F, int n0, int tid, f32x4 (&v)[16]) {
    const int c4 = tid & 3, r = tid >> 2;
    const float* wp = F.w_in + (size_t)r * NC + n0 + 4 * c4;
#pragma unroll
    for (int i = 0; i < 16; ++i) v[i] = *(const f32x4*)(wp + (size_t)(128 * i) * NC);
}
__device__ __forceinline__ void p0_quant_stage(const Frame& F, int tid, const f32x4 (&v)[16]) {
    LAS float* T = (LAS float*)F.lds;
    const int c4 = tid & 3, r = tid >> 2;
#pragma unroll
    for (int i = 0; i < 16; ++i) { const int k = r + 128 * i; LAS float* d = T + (4 * c4) * Q_CP + (k >> 6) * Q_KB + (k & 63);
        d[0] = v[i][0]; d[Q_CP] = v[i][1]; d[2 * Q_CP] = v[i][2]; d[3 * Q_CP] = v[i][3]; }
}
__device__ __forceinline__ void p0_quant_emit(const Frame& F, int n0, int tid) {
    const LAS float* T = (const LAS float*)F.lds;
    const int c = tid >> 5, kb = tid & 31;
    const LAS f32x4* src = (const LAS f32x4*)(T + c * Q_CP + kb * Q_KB);
    f32x4 v[16];
#pragma unroll
    for (int q = 0; q < 16; ++q) v[q] = src[q];
    f32x4 m4 = (f32x4){0.f, 0.f, 0.f, 0.f};
#pragma unroll
    for (int q = 0; q < 16; ++q) m4 = __builtin_elementwise_max(m4, __builtin_elementwise_abs(v[q]));
    float mx = fmaxf(fmaxf(m4[0], m4[1]), fmaxf(m4[2], m4[3]));
#pragma unroll
    for (int o = 1; o < 32; o <<= 1) mx = fmaxf(mx, __shfl_xor(mx, o));
    const float inv = mx > 0.f ? 127.f / mx : 0.f;
    const int row = win_row(n0 + c);
    if (kb == 0) F.SW[row] = mx > 0.f ? mx * (1.f / 127.f) : 1.f;
    unsigned d[16];
#pragma unroll
    for (int q = 0; q < 16; ++q) d[q] = pk4_i8(v[q][0] * inv, v[q][1] * inv, v[q][2] * inv, v[q][3] * inv);
    unsigned char* dst = F.Wi8 + (size_t)row * D + 64 * kb;
#pragma unroll
    for (int q = 0; q < 4; ++q) *(u32x4*)(dst + 16 * q) = (u32x4){d[4 * q], d[4 * q + 1], d[4 * q + 2], d[4 * q + 3]};
}
__device__ __forceinline__ void p0_xrow_emit(Frame& F, int row, int lane, const f32x4 (&v)[8]) {
    float mx = 0.f;
#pragma unroll
    for (int j = 0; j < 8; ++j) mx = fmaxf(fmaxf(mx, fmaxf(fabsf(v[j][0]), fabsf(v[j][1]))), fmaxf(fabsf(v[j][2]), fabsf(v[j][3])));
#pragma unroll
    for (int o = 1; o < 64; o <<= 1) mx = fmaxf(mx, __shfl_xor(mx, o));
    const float inv = mx > 0.f ? 127.f / mx : 0.f;
    if (lane == 0) F.SX[row] = mx > 0.f ? mx * (1.f / 127.f) : 1.f;
    unsigned char* xq = F.Xi8 + (size_t)row * D + 4 * lane;
#pragma unroll
    for (int j = 0; j < 8; ++j) *(unsigned*)(xq + 256 * j) = pk4_i8(v[j][0] * inv, v[j][1] * inv, v[j][2] * inv, v[j][3] * inv);
    if (MK_NBI < 32) {
        bf16_t* xb = F.Xb + (size_t)row * D + 4 * lane;
#pragma unroll
        for (int j = 0; j < 8; ++j) *(u32x2*)(xb + 256 * j) = (u32x2){ST_PK(v[j][0], v[j][1]), ST_PK(v[j][2], v[j][3])};
    }
}
__device__ __forceinline__ void p0_xrows(Frame& F, int gw, int NGW, int lane) {
    for (int row = gw; row < M; row += 2 * NGW) {
        const int row2 = row + NGW;
        const float* xp = F.x + (size_t)row * D + 4 * lane; const float* xp2 = F.x + (size_t)(row2 < M ? row2 : row) * D + 4 * lane;
        f32x4 v[8], w[8];
#pragma unroll
        for (int j = 0; j < 8; ++j) { v[j] = *(const f32x4*)(xp + 256 * j); w[j] = *(const f32x4*)(xp2 + 256 * j); }
        p0_xrow_emit(F, row, lane, v);
        if (row2 < M) p0_xrow_emit(F, row2, lane, w);
    }
}
constexpr int P0_ROWS_PER_QITEM = 16;
__device__ __forceinline__ void p0_xrows_range(Frame& F, int start, int nrows, int wave, int lane) {
    for (int k = wave; k < nrows; k += 16) {
        const int row = start + k, row2 = row + 8; const bool two = (k + 8) < nrows;
        const float* xp = F.x + (size_t)row * D + 4 * lane; const float* xp2 = F.x + (size_t)(two ? row2 : row) * D + 4 * lane;
        f32x4 v[8], w[8];
#pragma unroll
        for (int j = 0; j < 8; ++j) { v[j] = *(const f32x4*)(xp + 256 * j); w[j] = *(const f32x4*)(xp2 + 256 * j); }
        p0_xrow_emit(F, row, lane, v);
        if (two) p0_xrow_emit(F, row2, lane, w);
    }
}
template <int PART> __device__ __forceinline__ void p0_prologue(Frame& F) {
    constexpr int NCH16 = 4 * MK_NBI;
    constexpr int NQ = 384 + 4 * NCH16 + 256;
    auto grp = [&](int it0) -> int {
        const int it = MK_QPAIR ? (it0 & ~255) + 2 * (8 * (((it0 & 255) >> 3) >> 1) + (it0 & 7)) + (((it0 & 255) >> 3) & 1) : it0;
        if (it < 384) return it;
        if (it < 384 + 4 * NCH16) { const int q = it - 384; return 384 + (q / (NCH16 ? NCH16 : 1)) * 128 + q % (NCH16 ? NCH16 : 1); }
        return 896 + (it - 384 - 4 * NCH16); };
    if ((PART & 1) && F.bx < NQ) {
        f32x4 v[16];
        p0_quant_load(F, 16 * grp(F.bx), F.tid, v);
        for (int it = F.bx; it < NQ; it += F.G) {
            p0_quant_stage(F, F.tid, v);
            __syncthreads();
            if (it + F.G < NQ) p0_quant_load(F, 16 * grp(it + F.G), F.tid, v);
            p0_quant_emit(F, 16 * grp(it), F.tid);
            __syncthreads();
        }
    }
    LAS float* scr = (LAS float*)(F.lds + F.wave * 16384);
    const int gw = F.bx * 8 + F.wave, NGW = F.G * 8;
    constexpr int NB32 = 2 * (32 - MK_NBI);
    constexpr int I_BF = (D / 64) * 4 * NB32, I_SQ = (D / 64) * (D / 32);
    if (PART & 2) for (int it = gw; it < I_BF + 3 * I_SQ; it += NGW) {
        int r = it;
        if (r < I_BF) { const int kb = r / (4 * NB32), q = r % (4 * NB32), nb = 192 + (q / NB32) * 64 + 2 * MK_NBI + q % NB32;
            p0_transpose_item<true>(F.w_in, D, NC, F.Win_t - (size_t)6144 * D, scr, kb, nb, F.lane); continue; } r -= I_BF;
        if (r < I_SQ) { p0_transpose_item<false>(F.w_oa, D, D, F.Woa_t, scr, r / (D / 32), r % (D / 32), F.lane); continue; } r -= I_SQ;
        if (r < I_SQ) { p0_transpose_item<false>(F.w_ob, D, D, F.Wob_t, scr, r / (D / 32), r % (D / 32), F.lane); continue; } r -= I_SQ;
        p0_transpose_item<false>(F.w_out, D, D, F.Wout_t, scr, r / (D / 32), r % (D / 32), F.lane);
    }
    if (PART & 4) {
        const int rem = NQ % F.G, tot = M + P0_ROWS_PER_QITEM * rem;
        if (MK_P0BAL && rem != 0 && tot % F.G == 0 && tot / F.G > P0_ROWS_PER_QITEM) {
            const int hi = tot / F.G, lo = hi - P0_ROWS_PER_QITEM;
            const int start = F.bx < rem ? F.bx * lo : rem * lo + (F.bx - rem) * hi;
            p0_xrows_range(F, start, F.bx < rem ? lo : hi, F.wave, F.lane);
        } else p0_xrows(F, gw, NGW, F.lane);
    }
}

constexpr int P2_PITCH = 272;
constexpr int P2_BIMG = 0, P2_WIMG = 256 * P2_PITCH, P2_PART = P2_WIMG + 128 * P2_PITCH, P2_TAB = P2_PART + 16384;
__device__ __forceinline__ void p2_sgu(Frame& F) {
    LAS unsigned char* lds = F.lds;
    int tid = threadIdx.x; asm volatile("" : "+v"(tid));
    const int lane = tid & 63, w = __builtin_amdgcn_readfirstlane(tid >> 6), fr = lane & 15, fq = lane >> 4;
    const int rg = tid >> 4, ck = tid & 15;
    const unsigned gvoff = (unsigned)(rg * 128 + ck * 8) * 2u;
    const unsigned evoff = (unsigned)(fr * D + 32 * w + 8 * fq) * 2u;
    const unsigned wvoff = (unsigned)(rg * 128 + ck * 8) * 4u;
    int hprev = -1;
    u32x4 gvr[8];
    const int p2G = MK_P2HALF ? F.G / 2 : F.G, p2b = (MK_P2HALF && F.bx >= p2G) ? 1024 : F.bx;
    if (p2b < 1024) {
        unsigned gvo = gvoff; asm volatile("" : "+v"(gvo));
        const char* gbase = (const char*)F.GVt + (size_t)((p2b >> 3) * 8 + (p2b & 7)) * 65536;
#pragma unroll
        for (int i = 0; i < 8; ++i) gvr[i] = *(const u32x4*)(gbase + (size_t)i * (32 * 128 * 2) + gvo);
    }
    for (int it = p2b; it < 1024; it += p2G) {
        const int h = it & 7, c = it >> 3;
        unsigned gvo = gvoff, evo = evoff, wvo = wvoff;
        asm volatile("" : "+v"(gvo), "+v"(evo), "+v"(wvo));
        const char* ebase = (const char*)F.EW + ((size_t)(c * 128) * D + h * 256) * 2;
        char* ybase = (char*)F.YA + ((size_t)(c * 128) * D + h * 256) * 2;
        u32x4 ew[8];
#pragma unroll
        for (int m = 0; m < 8; ++m) ew[m] = *(const u32x4*)(ebase + (size_t)m * (16 * D * 2) + evo);
        LDS_BARRIER();
        if (h != hprev) {
            hprev = h;
            {
                LAS float* tab = (LAS float*)(lds + P2_TAB);
                if (tid < 256) { tab[tid] = F.ln_v_g[h * 256 + tid]; tab[256 + tid] = F.ln_v_b[h * 256 + tid]; }
                else if (tid < 384) tab[512 + (tid - 256)] = F.b_s[h * 128 + (tid - 256)];
            }
            const char* wbase = (const char*)F.w_s + (size_t)h * (128 * 128 * 4);
#pragma unroll
            for (int e = 0; e < 4; ++e) {
                const int t = rg + 32 * e;
                const f32x4 a = *(const f32x4*)(wbase + (size_t)e * (32 * 128 * 4) + wvo), b = *(const f32x4*)(wbase + (size_t)e * (32 * 128 * 4) + 16 + wvo);
                float v[8] = {a[0], a[1], a[2], a[3], b[0], b[1], b[2], b[3]};
#pragma unroll
                for (int j = 0; j < 8; ++j) v[j] = (ck * 8 + j <= t) ? v[j] : 0.f;
                u32x4 o; o.x = ST_PK(v[0], v[1]); o.y = ST_PK(v[2], v[3]); o.z = ST_PK(v[4], v[5]); o.w = ST_PK(v[6], v[7]);
                *(LAS u32x4*)(lds + P2_WIMG + (rg * P2_PITCH + (ck << 4)) + e * (32 * P2_PITCH)) = o;
            }
        }
        float sm[8], sq[8];
#pragma unroll
        for (int j = 0; j < 8; ++j) { sm[j] = 0.f; sq[j] = 0.f; }
#pragma unroll
        for (int i = 0; i < 8; ++i) {
            const unsigned ww[4] = {gvr[i].x, gvr[i].y, gvr[i].z, gvr[i].w};
#pragma unroll
            for (int p = 0; p < 4; ++p) { const float lo = ST_LO(ww[p]), hi = ST_HI(ww[p]); sm[2 * p] += lo; sq[2 * p] += lo * lo; sm[2 * p + 1] += hi; sq[2 * p + 1] += hi * hi; }
        }
#pragma unroll
        for (int j = 0; j < 8; ++j) { sm[j] += __shfl_xor(sm[j], 16); sm[j] += __shfl_xor(sm[j], 32); sq[j] += __shfl_xor(sq[j], 16); sq[j] += __shfl_xor(sq[j], 32); }
        if (lane < 16) {
            LAS f32x4* pp = (LAS f32x4*)(lds + P2_PART + (w * 128 + ck * 8) * 8);
#pragma unroll
            for (int j = 0; j < 4; ++j) pp[j] = (f32x4){sm[2 * j], sq[2 * j], sm[2 * j + 1], sq[2 * j + 1]};
        }
        LDS_BARRIER();
        if (tid < 128) {
            float s1 = 0.f, s2 = 0.f;
#pragma unroll
            for (int ww = 0; ww < 8; ++ww) { const f32x2 v = *(const LAS f32x2*)(lds + P2_PART + tid * 8 + ww * (128 * 8)); s1 += v.x; s2 += v.y; }
            const float mean = s1 * (1.f / 256.f), var = s2 * (1.f / 256.f) - mean * mean;
            *(LAS f32x2*)(lds + P2_PART + 8192 + tid * 8) = (f32x2){mean, rsqrtf(fmaxf(var, 0.f) + LN_EPS)};
        }
        LDS_BARRIER();
        float mu[8], rs[8];
        {
            const LAS f32x4* pp = (const LAS f32x4*)(lds + P2_PART + 8192 + (ck * 8) * 8);
#pragma unroll
            for (int j = 0; j < 4; ++j) { const f32x4 v = pp[j]; mu[2 * j] = v[0]; rs[2 * j] = v[1]; mu[2 * j + 1] = v[2]; rs[2 * j + 1] = v[3]; }
        }
        float nmr[8];
#pragma unroll
        for (int j = 0; j < 8; ++j) nmr[j] = -mu[j] * rs[j];
#pragma unroll
        for (int i = 0; i < 8; ++i) {
            const float g = ((const LAS float*)(lds + P2_TAB))[rg + 32 * i], b = ((const LAS float*)(lds + P2_TAB))[256 + rg + 32 * i];
            const unsigned ww[4] = {gvr[i].x, gvr[i].y, gvr[i].z, gvr[i].w};
            float v[8];
#pragma unroll
            for (int p = 0; p < 4; ++p) { v[2 * p] = fmaf(fmaf(ST_LO(ww[p]), rs[2 * p], nmr[2 * p]), g, b); v[2 * p + 1] = fmaf(fmaf(ST_HI(ww[p]), rs[2 * p + 1], nmr[2 * p + 1]), g, b); }
            u32x4 o; o.x = ST_PK(v[0], v[1]); o.y = ST_PK(v[2], v[3]); o.z = ST_PK(v[4], v[5]); o.w = ST_PK(v[6], v[7]);
            *(LAS u32x4*)(lds + P2_BIMG + (rg * P2_PITCH + (ck << 4)) + i * (32 * P2_PITCH)) = o;
        }
        __builtin_amdgcn_sched_barrier(0);
        {
            const int it2 = it + p2G;
            if (it2 < 1024) {
                const char* gbase2 = (const char*)F.GVt + (size_t)((it2 >> 3) * 8 + (it2 & 7)) * 65536;
#pragma unroll
                for (int i = 0; i < 8; ++i) gvr[i] = *(const u32x4*)(gbase2 + (size_t)i * (32 * 128 * 2) + gvo);
            }
        }
        LDS_BARRIER();
        bf16x8 Bf[2][4];
        const int brow = 32 * w + 8 * (fr >> 2) + (fr & 3);
        const LAS unsigned char* bptr = lds + P2_BIMG + brow * P2_PITCH + (fq << 4);
        const LAS unsigned char* wptr = lds + P2_WIMG + fr * P2_PITCH + (fq << 4);
#pragma unroll
        for (int itl = 0; itl < 2; ++itl)
#pragma unroll
            for (int kk = 0; kk < 4; ++kk) Bf[itl][kk] = *(const LAS bf16x8*)(bptr + itl * (4 * P2_PITCH) + kk * 64);
        f32x4 acc[8][2];
#pragma unroll
        for (int m = 0; m < 8; ++m) { const float bs = ((const LAS float*)(lds + P2_TAB))[512 + fr + 16 * m]; acc[m][0] = (f32x4){bs, bs, bs, bs}; acc[m][1] = (f32x4){bs, bs, bs, bs}; }
#pragma unroll
        for (int m = 0; m < 8; ++m) {
            __builtin_amdgcn_sched_barrier(0);
#pragma unroll
            for (int kk = 0; kk < 4; ++kk) {
                if (kk <= (m >> 1)) {
                    const bf16x8 wf = *(const LAS bf16x8*)(wptr + m * (16 * P2_PITCH) + kk * 64);
                    acc[m][0] = MFMA_16(Bf[0][kk], wf, acc[m][0]);
                    acc[m][1] = MFMA_16(Bf[1][kk], wf, acc[m][1]);
                }
            }
        }
        __builtin_amdgcn_sched_barrier(0);
#pragma unroll
        for (int m = 0; m < 8; ++m) {
            const float bs = 0.f;
            const u32x4 e = ew[m];
            u32x4 o;
            o.x = OP_PK(ST_LO(e.x) * (acc[m][0][0] + bs), ST_HI(e.x) * (acc[m][0][1] + bs));
            o.y = OP_PK(ST_LO(e.y) * (acc[m][0][2] + bs), ST_HI(e.y) * (acc[m][0][3] + bs));
            o.z = OP_PK(ST_LO(e.z) * (acc[m][1][0] + bs), ST_HI(e.z) * (acc[m][1][1] + bs));
            o.w = OP_PK(ST_LO(e.w) * (acc[m][1][2] + bs), ST_HI(e.w) * (acc[m][1][3] + bs));
            *(u32x4*)(ybase + (size_t)m * (16 * D * 2) + evo) = o;
        }
    }
    __syncthreads();
}
__device__ __forceinline__ void p2_fix(Frame& F) {
    int tid = threadIdx.x; asm volatile("" : "+v"(tid));
    const int r = tid >> 8, ch = (tid & 255) * 8;
    const bf16_t* HALO = F.FIX; const bf16_t* H01 = F.FIX + 64 * 2 * D; const bf16_t* G01 = F.FIX + 2 * 64 * 2 * D;
    for (int pm = F.bx; pm < 64; pm += F.G) {
        const bool first = (pm & 31) == 0;
        const u32x4 z4 = (u32x4){0u, 0u, 0u, 0u};
        const u32x4 hA = first ? z4 : *(const u32x4*)(HALO + ((size_t)(pm - 1) * 2 + 0) * D + ch);
        const u32x4 hB = first ? z4 : *(const u32x4*)(HALO + ((size_t)(pm - 1) * 2 + 1) * D + ch);
        const u32x4 h00 = *(const u32x4*)(H01 + ((size_t)pm * 2 + 0) * D + ch), h01 = *(const u32x4*)(H01 + ((size_t)pm * 2 + 1) * D + ch);
        const u32x4 gv = *(const u32x4*)(G01 + ((size_t)pm * 2 + r) * D + ch);
        const u32x4 v0 = r == 0 ? h00 : h01, v1 = r == 0 ? hB : h00, v2 = r == 0 ? hA : hB;
        const unsigned a0[4] = {v0.x, v0.y, v0.z, v0.w}, a1[4] = {v1.x, v1.y, v1.z, v1.w}, a2[4] = {v2.x, v2.y, v2.z, v2.w}, ag[4] = {gv.x, gv.y, gv.z, gv.w};
        unsigned o[4];
#pragma unroll
        for (int p = 0; p < 4; ++p) {
            const int c0 = ch + 2 * p;
            const float y0 = ST_LO(ag[p]) * (F.conv_b[c0] + F.conv_w[c0] * ST_LO(a2[p]) + F.conv_w[D + c0] * ST_LO(a1[p]) + F.conv_w[2 * D + c0] * ST_LO(a0[p]));
            const float y1 = ST_HI(ag[p]) * (F.conv_b[c0 + 1] + F.conv_w[c0 + 1] * ST_HI(a2[p]) + F.conv_w[D + c0 + 1] * ST_HI(a1[p]) + F.conv_w[2 * D + c0 + 1] * ST_HI(a0[p]));
            o[p] = OP_PK(y0, y1);
        }
        *(u32x4*)(F.YB + (size_t)(pm * 256 + r) * D + ch) = (u32x4){o[0], o[1], o[2], o[3]};
    }
}

__device__ __forceinline__ void p5_ln(Frame& F) {
    int tid = threadIdx.x; asm volatile("" : "+v"(tid));
    const int lane = tid & 63, gw = F.bx * 8 + __builtin_amdgcn_readfirstlane(tid >> 6), NGW = F.G * 8;
    f32x4 g[8], b[8];
#pragma unroll
    for (int j = 0; j < 8; ++j) { g[j] = *(const f32x4*)(F.ln_g + 4 * lane + 256 * j); b[j] = *(const f32x4*)(F.ln_b + 4 * lane + 256 * j); }
    for (int row = gw; row < M; row += NGW) {
        const float* xp = F.x + (size_t)row * D + 4 * lane; const bf16_t* op = F.OUTB + (size_t)row * D + 4 * lane; float* rp = F.out + (size_t)row * D + 4 * lane;
        f32x4 v[8]; u32x2 o[8];
#if MK_F16S && MK_NBI < 32 && MK_P5XH
        {
            const bf16_t* hp = F.Xb + (size_t)row * D + 4 * lane; u32x2 xh[8];
#pragma unroll
            for (int j = 0; j < 8; ++j) { xh[j] = *(const u32x2*)(hp + 256 * j); o[j] = *(const u32x2*)(op + 256 * j); }
#pragma unroll
            for (int j = 0; j < 8; ++j) v[j] = (f32x4){ST_LO(xh[j].x), ST_HI(xh[j].x), ST_LO(xh[j].y), ST_HI(xh[j].y)};
        }
        (void)xp;
#else
#pragma unroll
        for (int j = 0; j < 8; ++j) { v[j] = *(const f32x4*)(xp + 256 * j); o[j] = *(const u32x2*)(op + 256 * j); }
#endif
        float s = 0.f;
#pragma unroll
        for (int j = 0; j < 8; ++j) { v[j] = v[j] * DN_ALPHA + (f32x4){ST_LO(o[j].x), ST_HI(o[j].x), ST_LO(o[j].y), ST_HI(o[j].y)}; s += (v[j][0] + v[j][1]) + (v[j][2] + v[j][3]); }
#pragma unroll
        for (int of = 1; of < 64; of <<= 1) s += __shfl_xor(s, of);
        const float mean = s * (1.f / D); float q = 0.f;
#pragma unroll
        for (int j = 0; j < 8; ++j) { v[j] = v[j] - mean; q += (v[j][0] * v[j][0] + v[j][1] * v[j][1]) + (v[j][2] * v[j][2] + v[j][3] * v[j][3]); }
#pragma unroll
        for (int of = 1; of < 64; of <<= 1) q += __shfl_xor(q, of);
        const float rstd = rsqrtf(q * (1.f / D) + LN_EPS);
#pragma unroll
        for (int j = 0; j < 8; ++j) *(f32x4*)(rp + 256 * j) = v[j] * rstd * g[j] + b[j];
    }
}

struct Args { const float* in[14]; float* out; unsigned char* ws; int ph_lo, ph_hi; };
__global__ void __launch_bounds__(512, 2) mk_fwd(Args args) {
    extern __shared__ __attribute__((aligned(16))) unsigned char lds_raw[];
    Frame F;
    F.lds = (LAS unsigned char*)lds_raw;
    F.tid = threadIdx.x; F.lane = F.tid & 63; F.wave = __builtin_amdgcn_readfirstlane(F.tid >> 6); F.G = gridDim.x; F.bx = blockIdx.x;
    unsigned char* ws = args.ws;
    F.x = args.in[0]; F.w_in = args.in[1]; F.b_gate = args.in[2]; F.ln_v_g = args.in[3]; F.ln_v_b = args.in[4]; F.w_s = args.in[5]; F.b_s = args.in[6];
    F.conv_w = args.in[7]; F.conv_b = args.in[8]; F.w_oa = args.in[9]; F.w_ob = args.in[10]; F.w_out = args.in[11]; F.ln_g = args.in[12]; F.ln_b = args.in[13];
    F.out = args.out;
    F.Woa_t = (bf16_t*)(ws + WS_WOA); F.Wob_t = (bf16_t*)(ws + WS_WOB); F.Wout_t = (bf16_t*)(ws + WS_WOUT);
    F.Xb = (bf16_t*)(ws + WS_XB); F.EW = (bf16_t*)(ws + WS_EW); F.GVt = (bf16_t*)(ws + WS_GVT); F.FIX = (bf16_t*)(ws + WS_FIX);
    F.RT = (bf16_t*)(ws + WS_RT); F.GBb = (bf16_t*)(ws + WS_GB); F.YA = (bf16_t*)(ws + WS_YA); F.YB = (bf16_t*)(ws + WS_YB); F.MG = (bf16_t*)(ws + WS_MG);
    F.OUTB = (bf16_t*)(ws + WS_OUTB); F.Wi8 = ws + WS_WI8; F.Win_t = (bf16_t*)(ws + WS_WBF); F.Xi8 = ws + WS_XQ; F.SX = (float*)(ws + WS_SX); F.SW = (float*)(ws + WS_SW);
    for (int u = F.tid; u < (LDS_BYTES - LDSCTL_OFF) / 4; u += 512) ((LAS unsigned*)(F.lds + LDSCTL_OFF))[u] = 0u;
    __syncthreads();
    const int lo = args.ph_lo, hi = args.ph_hi;
    XcdBarrier bar; bar.bar = (unsigned*)(ws + WS_CTL); bar.x = 0; bar.st = nullptr;
    if (hi - lo > 1) bar = xcd_barrier_post((unsigned*)(ws + WS_CTL), (volatile LAS unsigned*)(F.lds + MISC_OFF));
#ifndef PH_MASK
#define PH_MASK 63
#endif
#define IN(k) (((PH_MASK >> (k)) & 1) && lo <= (k) && (k) < hi)
#define GRID_BAR(k) do { if (IN(k) && IN((k) + 1)) { xcd_barrier(bar); if (MK_DOUBLE == 20) xcd_barrier(bar); } } while (0)
#ifndef MK_DOUBLE
#define MK_DOUBLE -1
#endif
    if (IN(0)) { p0_prologue<7>(F); if (MK_DOUBLE == 0) { __syncthreads(); p0_prologue<7>(F); } if (MK_DOUBLE == 11) { __syncthreads(); p0_prologue<1>(F); } if (MK_DOUBLE == 12) { __syncthreads(); p0_prologue<2>(F); } if (MK_DOUBLE == 13) { __syncthreads(); p0_prologue<4>(F); } }
    GRID_BAR(0);
    if (IN(1)) { ProgP1 P{F.Xi8, F.Wi8, F.SX, F.SW, F.EW, F.GVt, F.YB, F.FIX, F.RT, F.GBb, F.b_gate, F.conv_w, F.conv_b, F.lds + HL_OFF, F.G, F.bx, (void*)(ws + WS_CTL + 49152)}; pg8::gemm_phase(F.lds, P); if (MK_DOUBLE == 1) pg8::gemm_phase(F.lds, P);
                 if (MK_NBI < 32) { ProgP1B PB{F.Xb, F.Win_t, F.YB, F.FIX, F.conv_w, F.conv_b, F.lds + HL_OFF, F.G, F.bx}; pg8::gemm_phase(F.lds, PB); if (MK_DOUBLE == 8) pg8::gemm_phase(F.lds, PB); }
                 if (MK_DOUBLE == 14) { ProgP4 P4{F.Xb, F.Wout_t, (bf16_t*)F.out, F.G, F.bx}; pg8::gemm_phase(F.lds, P4); } }
    GRID_BAR(1);
    if (IN(2)) { p2_fix(F); p2_sgu(F); if (MK_DOUBLE == 2) { p2_fix(F); p2_sgu(F); } }
    GRID_BAR(2);
    if (IN(3)) { ProgP3 P{F.YA, F.YB, F.Woa_t, F.Wob_t, F.RT, F.GBb, F.MG, F.G, F.bx}; pg8::gemm_phase(F.lds, P); if (MK_DOUBLE == 3) pg8::gemm_phase(F.lds, P); }
    GRID_BAR(3);
    if (IN(4)) { ProgP4 P{F.MG, F.Wout_t, F.OUTB, F.G, F.bx}; pg8::gemm_phase(F.lds, P); if (MK_DOUBLE == 4) pg8::gemm_phase(F.lds, P); }
    GRID_BAR(4);
    if (IN(5)) { p5_ln(F); if (MK_DOUBLE == 7) p5_ln(F); }
    if (MK_DOUBLE == 15) { ProgP1B PB{F.Xb, F.Win_t, F.YB, F.FIX, F.conv_w, F.conv_b, F.lds + HL_OFF, F.G, F.bx}; pg8::gemm_phase(F.lds, PB); }
    if (MK_DOUBLE == 17) { ProgP4 P4{F.MG, F.Wout_t, F.YB, F.G, F.bx}; pg8::gemm_phase(F.lds, P4); }
    if (MK_DOUBLE == 18) { ProgP4 P4{F.YB, F.Wout_t, F.MG, F.G, F.bx}; pg8::gemm_phase(F.lds, P4); }
    if (MK_DOUBLE == 19) { ProgP4 P4{F.MG, F.Wout_t, F.OUTB, F.G, F.bx}; pg8::gemm_phase(F.lds, P4); }
    if (MK_DOUBLE == 16) { ProgP4 P4{F.Xb, F.Wout_t, F.MG, F.G, F.bx}; pg8::gemm_phase(F.lds, P4); }
#undef IN
#undef GRID_BAR
}


extern "C" void kernel_launch(void* const* d_in, const int* in_sizes, int n_in, void* d_out, int out_size, void* d_ws, size_t ws_size, hipStream_t stream) {
    static int grid = 0;
    if (grid == 0) {
        if (n_in != 14 || in_sizes[0] != M * D || out_size != M * D || ws_size < WS_END) {
            fprintf(stderr, "kernel_launch: unexpected shapes: n_in %d in0 %d out %d ws %zu (need %zu)\n", n_in, n_in > 0 ? in_sizes[0] : -1, out_size, ws_size, (size_t)WS_END); grid = -1; return; }
        int dev = 0, cus = 0, per_cu = 0;
        if (hipGetDevice(&dev) != hipSuccess || hipDeviceGetAttribute(&cus, hipDeviceAttributeMultiprocessorCount, dev) != hipSuccess) { grid = -1; return; }
        if (hipFuncSetAttribute((const void*)mk_fwd, hipFuncAttributeMaxDynamicSharedMemorySize, LDS_BYTES) != hipSuccess) { fprintf(stderr, "kernel_launch: hipFuncSetAttribute failed\n"); grid = -1; return; }
        if (hipOccupancyMaxActiveBlocksPerMultiprocessor(&per_cu, (const void*)mk_fwd, 512, LDS_BYTES) != hipSuccess || per_cu < 1) {
            fprintf(stderr, "kernel_launch: occupancy query says %d blocks per CU; cannot run the persistent grid\n", per_cu); (void)hipGetLastError(); grid = -1; return; }
        grid = cus;
        if (grid % 8 != 0) fprintf(stderr, "kernel_launch: note: grid %d is not a multiple of 8\n", grid);
    }
    if (grid < 0) return;
    (void)hipMemsetAsync((char*)d_ws + WS_CTL, 0, CTL_ZERO_BYTES, stream);
    Args a{};
    for (int i = 0; i < 14; ++i) a.in[i] = (const float*)d_in[i];
    a.out = (float*)d_out; a.ws = (unsigned char*)d_ws;
    if (MK_N_LAUNCHES == 1) {
        a.ph_lo = 0; a.ph_hi = NPH;
        hipLaunchKernelGGL(mk_fwd, dim3(grid), dim3(512), LDS_BYTES, stream, a);
    } else {
        for (int p = 0; p < NPH; ++p) { a.ph_lo = p; a.ph_hi = p + 1; hipLaunchKernelGGL(mk_fwd, dim3(grid), dim3(512), LDS_BYTES, stream, a); }
    }
    const hipError_t le = hipPeekAtLastError();
    if (le != hipSuccess) fprintf(stderr, "kernel_launch: launch failed: %s\n", hipGetErrorName(le));
}
```

```cpp
#define MK_NBI 32
#include <hip/hip_runtime.h>
#include <cstdio>
#include <cstdint>

#ifndef MK_SP2
#define MK_SP2 1
#endif
#ifndef MK_ALIGN
#define MK_ALIGN 1
#endif
#ifndef MK_SYNC_K
#define MK_SYNC_K 0
#endif
#ifndef MK_EPI2
#define MK_EPI2 0
#endif
#ifndef MK_WGM1
#define MK_WGM1 4
#endif
#ifndef MK_WGM1B
#define MK_WGM1B 4
#endif
#ifndef MK_WGM3
#define MK_WGM3 4
#endif
#ifndef MK_WGM4
#define MK_WGM4 4
#endif
#ifndef MK_KS2_DIV
#define MK_KS2_DIV 1
#endif
#ifndef MK_KS2_MOD
#define MK_KS2_MOD 1
#endif
#ifndef MK_KS2_MUL
#define MK_KS2_MUL 0
#endif
#ifndef MK_PNROT
#define MK_PNROT 1
#endif
#ifndef MK_NT1
#define MK_NT1 0
#endif
#ifndef MK_NT1B
#define MK_NT1B 0
#endif
#ifndef MK_NT3
#define MK_NT3 0
#endif
#ifndef MK_NT4
#define MK_NT4 0
#endif
#ifndef MK_QPAIR
#define MK_QPAIR 1
#endif
#ifndef MK_F16S
#define MK_F16S 1
#endif
#ifndef MK_NTST
#define MK_NTST 0
#endif
#ifndef MK_P5XH
#define MK_P5XH 1
#endif
#ifndef MK_F16M
#define MK_F16M 0
#endif
#ifndef MK_P0BAL
#define MK_P0BAL 1
#endif
#ifndef MK_P4REV
#define MK_P4REV 0
#endif
#ifndef MK_P2HALF
#define MK_P2HALF 0
#endif
#ifndef MK_PF
#define MK_PF 0
#endif
#ifndef MK_EWFRAG
#define MK_EWFRAG 1
#endif
#ifndef MK_GFRAG
#define MK_GFRAG 1
#endif
#ifndef MK_KSTAG
#define MK_KSTAG 1
#endif
#ifndef MK_NBI
#define MK_NBI 28
#endif
#ifndef MK_N_LAUNCHES
#define MK_N_LAUNCHES 1
#endif

#define LAS __attribute__((address_space(3)))
#define GAS __attribute__((address_space(1)))
typedef unsigned short bf16_t;
typedef short bf16x8 __attribute__((ext_vector_type(8)));
typedef float f32x4 __attribute__((ext_vector_type(4)));
typedef float f32x2 __attribute__((ext_vector_type(2)));
typedef unsigned u32x4 __attribute__((ext_vector_type(4)));
typedef unsigned u32x2 __attribute__((ext_vector_type(2)));

constexpr int M = 16384, D = 2048, NC = 18432, SEQ = 8192;
constexpr float LN_EPS = 1e-5f;
constexpr float DN_ALPHA = 1.189207115002721f;
constexpr int NPH = 6;

constexpr size_t MiB = 1u << 20;
constexpr size_t WS_CTL = 0, CTL_ZERO_BYTES = 64 * 1024;
constexpr size_t WS_WOA = 1 * MiB, WS_WOB = 9 * MiB, WS_WOUT = 17 * MiB;
constexpr size_t WS_WI8 = 25 * MiB;
constexpr size_t WS_WBF = 61 * MiB;
constexpr size_t WS_XB = 93 * MiB;
constexpr size_t WS_XQ = 157 * MiB;
constexpr size_t WS_EW = 189 * MiB, WS_GVT = 253 * MiB, WS_YB = 317 * MiB;
constexpr size_t WS_FIX = 381 * MiB;
constexpr size_t WS_SX = 383 * MiB, WS_SW = 384 * MiB;
constexpr size_t WS_RT = 441 * MiB, WS_GB = 505 * MiB;
constexpr size_t WS_YA = 25 * MiB;
constexpr size_t WS_MG = 189 * MiB;
constexpr size_t WS_OUTB = 253 * MiB;
constexpr size_t WS_END = 569 * MiB;

constexpr int RING_BYTES = 131072;
constexpr int LDSCTL_OFF = 163840 - 512, MISC_OFF = LDSCTL_OFF + 320;
constexpr int LDS_BYTES = 163840;
constexpr int HL_OFF = RING_BYTES, HL_PITCH = 136;

typedef __bf16 bf16x2_t __attribute__((ext_vector_type(2)));
__device__ __forceinline__ unsigned cvt_pk_bf16(float lo, float hi) { const bf16x2_t v = __builtin_convertvector((f32x2){lo, hi}, bf16x2_t); return __builtin_bit_cast(unsigned, v); }
typedef _Float16 f16x2_t __attribute__((ext_vector_type(2)));
__device__ __forceinline__ unsigned cvt_pk_f16(float lo, float hi) { const f16x2_t v = __builtin_convertvector((f32x2){lo, hi}, f16x2_t); return __builtin_bit_cast(unsigned, v); }
__device__ __forceinline__ f32x2 h2f(unsigned w) { return __builtin_convertvector(__builtin_bit_cast(f16x2_t, w), f32x2); }
typedef _Float16 f16x8 __attribute__((ext_vector_type(8)));
#define MFMA_F16(a, b, c) __builtin_amdgcn_mfma_f32_16x16x32_f16(__builtin_bit_cast(f16x8, a), __builtin_bit_cast(f16x8, b), c, 0, 0, 0)
#define MFMA_BF16(a, b, c) __builtin_amdgcn_mfma_f32_16x16x32_bf16(a, b, c, 0, 0, 0)
#if MK_F16M
#define OP_PK(lo, hi) cvt_pk_f16(lo, hi)
#else
#define OP_PK(lo, hi) cvt_pk_bf16(lo, hi)
#endif
#if MK_F16S
#define MFMA_16(a, b, c) __builtin_amdgcn_mfma_f32_16x16x32_f16(__builtin_bit_cast(f16x8, a), __builtin_bit_cast(f16x8, b), c, 0, 0, 0)
#else
#define MFMA_16(a, b, c) __builtin_amdgcn_mfma_f32_16x16x32_bf16(a, b, c, 0, 0, 0)
#endif
#if MK_F16S
#define ST_PK(lo, hi) cvt_pk_f16(lo, hi)
#define ST_LO(w) (h2f(w).x)
#define ST_HI(w) (h2f(w).y)
#else
#define ST_PK(lo, hi) cvt_pk_bf16(lo, hi)
#define ST_LO(w) bf_lo(w)
#define ST_HI(w) bf_hi(w)
#endif
#if MK_NTST
#define NT_ST(p, v) __builtin_nontemporal_store((v), (p))
#else
#define NT_ST(p, v) (*(p) = (v))
#endif
__device__ __forceinline__ float bf_lo(unsigned w) { return __builtin_bit_cast(float, w << 16); }
__device__ __forceinline__ float bf_hi(unsigned w) { return __builtin_bit_cast(float, w & 0xffff0000u); }
__device__ __forceinline__ float ex2(float x) { return __builtin_amdgcn_exp2f(x); }
__device__ __forceinline__ float rcp(float x) { return __builtin_amdgcn_rcpf(x); }
constexpr float LOG2E = 1.4426950408889634f;
constexpr float GELU_C1 = -(float)(1.5957691216057308 * 1.4426950408889634);
constexpr float GELU_C3 = -(float)(1.5957691216057308 * 1.4426950408889634 * 0.044715);
__device__ __forceinline__ float gelu_den(float x) { return 1.0f + ex2(x * (GELU_C1 + GELU_C3 * x * x)); }
__device__ __forceinline__ float sig_den(float x) { return 1.0f + ex2(-LOG2E * x); }

#define VM_WAIT() asm volatile("s_waitcnt vmcnt(0)" ::: "memory")
#define LDS_BARRIER() asm volatile("s_waitcnt lgkmcnt(0)\n\ts_barrier" ::: "memory")
#define LDS_WAIT() asm volatile("s_waitcnt lgkmcnt(0)" ::: "memory")

#define XB_TMO      128
#define XB_XCNT(j)  (256  + 64 * (j))
#define XB_XSUB(j)  (1280 + 64 * (j))
#define XB_XGEN(j)  (2304 + 64 * (j))
#define XB_TOP      3328
#define XB_TOPGEN   3392
#define XCD_BAR_WORDS 3456
#define XB_SPIN_CAP (1u << 18)
__device__ __forceinline__ unsigned xb_ld(unsigned* p)              { return __hip_atomic_load(p, __ATOMIC_RELAXED, __HIP_MEMORY_SCOPE_AGENT); }
__device__ __forceinline__ unsigned xb_add(unsigned* p, unsigned v) { return __hip_atomic_fetch_add(p, v, __ATOMIC_RELAXED, __HIP_MEMORY_SCOPE_AGENT); }
__device__ __forceinline__ unsigned xb_xcc_id() { return (unsigned)__builtin_amdgcn_s_getreg((3 << 11) | 20) & 0xFu; }
#define XB_SPIN(cond, bar) do { unsigned _sp = 0; while (cond) { __builtin_amdgcn_s_sleep(1); \
    if ((++_sp & 255u) == 0u) { if (xb_ld(&(bar)[XB_TMO])) break; if (_sp > XB_SPIN_CAP) { atomicAdd(&(bar)[XB_TMO], 1u); break; } } } } while (0)
struct XcdBarrier { unsigned* bar; unsigned x; volatile LAS unsigned* st; };
__device__ __forceinline__ XcdBarrier xcd_barrier_post(unsigned* bar, volatile LAS unsigned* st) {
    XcdBarrier b; b.bar = bar; b.x = xb_xcc_id(); b.st = st;
    if (threadIdx.x == 0) (void)xb_add(&bar[XB_XCNT(b.x)], 1u);
    return b;
}
__device__ __forceinline__ void xcd_barrier_complete(unsigned* bar, unsigned x, unsigned& nloc, unsigned& nx) {
    const unsigned G = gridDim.x * gridDim.y * gridDim.z;
    unsigned sum, cnt, mine, sp = 0u;
    for (;;) {
        sum = 0u; cnt = 0u; mine = 0u;
#pragma unroll
        for (unsigned j = 0; j < 16; ++j) { const unsigned c = xb_ld(&bar[XB_XCNT(j)]); sum += c; cnt += (c > 0u) ? 1u : 0u; mine = (j == x) ? c : mine; }
        if (sum == G) break;
        __builtin_amdgcn_s_sleep(1);
        if ((++sp & 255u) == 0u) { if (xb_ld(&bar[XB_TMO])) break; if (sp > XB_SPIN_CAP) { atomicAdd(&bar[XB_TMO], 1u); break; } }
    }
    nloc = mine > 0u ? mine : 1u; nx = cnt > 0u ? cnt : 1u;
}
__device__ __forceinline__ void xcd_barrier(const XcdBarrier& b) {
    asm volatile("s_waitcnt vmcnt(0)" ::: "memory");
    __syncthreads();
    if (threadIdx.x == 0) {
        unsigned* bar = b.bar;
        __builtin_amdgcn_s_waitcnt(0);
        unsigned nloc = b.st[0], nx = b.st[1];
        if (nloc == 0u) { xcd_barrier_complete(bar, b.x, nloc, nx); b.st[0] = nloc; b.st[1] = nx; }
        const unsigned old = xb_add(&bar[XB_XSUB(b.x)], 1u);
        const unsigned gen = old / nloc;
        if (old + 1u == (gen + 1u) * nloc) {
            __builtin_amdgcn_fence(__ATOMIC_RELEASE, "agent");
            asm volatile("s_waitcnt vmcnt(0)" ::: "memory");
            const unsigned og = xb_add(&bar[XB_TOP], 1u);
            const unsigned tg = og / nx;
            if (og + 1u == (tg + 1u) * nx) xb_add(&bar[XB_TOPGEN], 1u);
            else XB_SPIN(xb_ld(&bar[XB_TOPGEN]) == tg, bar);
            __builtin_amdgcn_fence(__ATOMIC_ACQUIRE, "agent");
            xb_add(&bar[XB_XGEN(b.x)], 1u);
            asm volatile("s_waitcnt vmcnt(0)" ::: "memory");
        } else {
            XB_SPIN(xb_ld(&bar[XB_XGEN(b.x)]) == gen, bar);
            __builtin_amdgcn_fence(__ATOMIC_ACQUIRE, "agent");
            asm volatile("s_waitcnt vmcnt(0)" ::: "memory");
        }
    }
    __syncthreads();
}

namespace pg8 {
constexpr int PF_OFF = LDSCTL_OFF - 8192;
constexpr int BM = 256, BK = 64, HALF = 128, HTB = HALF * BK * 2, STAGE_BYTES = 8 * HTB, NXCD = 8, KD = 2048;
__device__ __forceinline__ int lds_byte(int r, int c) { const int st = (r >> 4) * 2 + (c >> 5), rr = r & 15, cc = c & 31, ob = rr * 64 + cc * 2; return st * 1024 + (ob ^ (((ob >> 9) & 1) << 5)); }
__device__ __forceinline__ void stage_rc(int b, int& R, int& C) { const int st = b / 1024, sb = b % 1024, swz = sb ^ (((sb >> 9) & 1) << 5); R = (st >> 1) * 16 + swz / 64; C = (st & 1) * 32 + (swz % 64) / 2; }
__device__ __forceinline__ int perm32(int rho) { const int n = rho >> 4, i = rho & 15; return 8 * (i >> 2) + 4 * n + (i & 3); }

struct Unit { const char* A; const char* B; int kind, pm, pn; };
typedef int i32x8 __attribute__((ext_vector_type(8)));
typedef int i32x4v __attribute__((ext_vector_type(4)));
template <bool F8, bool I8> struct FragSel { typedef bf16x8 type; };
template <> struct FragSel<true, false> { typedef i32x8 type; };
template <> struct FragSel<false, true> { typedef i32x4v type; };
template <bool I8> struct AccSel { typedef f32x4 type; };
template <> struct AccSel<true> { typedef i32x4v type; };

__device__ __forceinline__ void tile_of(int L, int nM, int nN, int& pm, int& pn, const int WGM = 8) {
    const int nwg = nM * nN; int wgid = L;
    { const int q = nwg / NXCD, r = nwg % NXCD, xcd = wgid % NXCD, off = wgid / NXCD; wgid = (xcd < r ? xcd * (q + 1) : r * (q + 1) + (xcd - r) * q) + off; }
    const int nig = WGM * nN, gid = wgid / nig, fm = gid * WGM, gsz = (nM - fm) < WGM ? (nM - fm) : WGM;
    pm = fm + ((wgid % nig) % gsz); pn = (wgid % nig) / gsz;
}

template <class Prog>
__device__ __forceinline__ void gemm_phase(LAS unsigned char* lds, const Prog& P) {
    int tid = threadIdx.x; asm volatile("" : "+v"(tid));
    const int wid = __builtin_amdgcn_readfirstlane(tid >> 6), lane = tid & 63, wr = wid >> 2, wc = wid & 3, fr = lane & 15, fq = lane >> 4;
    constexpr bool FP8 = Prog::FP8;
    constexpr bool I8 = Prog::I8;
    constexpr int PB = (FP8 || I8) ? KD : 2 * KD, nt = (FP8 || I8) ? KD / 128 : KD / BK;
    using FragT = typename FragSel<FP8, I8>::type; using AccT = typename AccSel<I8>::type; constexpr int NF = FP8 ? 1 : 2;
    unsigned voffA[2], voffB[2];
#pragma unroll
    for (int i = 0; i < 2; ++i) { int R, C; stage_rc(tid * 16 + i * 8192, R, C); const int Rb = (R & ~31) + perm32(R & 31);
        voffA[i] = (unsigned)(R * PB + C * 2); voffB[i] = (unsigned)(Rb * PB + C * 2); }
    const size_t kstep = (size_t)(BK * 2);
    const size_t hstep = (size_t)HALF * PB;
    const unsigned ldsw = (unsigned)wid * 1024u;
    const int aoff = lds_byte(wr * 64 + fr, fq * 8), boff = lds_byte(wc * 32 + fr, fq * 8);
#define PG8_SA(b, h) (((b) * 2 + (h)) * HTB)
#define PG8_SB(b, h) ((4 + (b) * 2 + (h)) * HTB)
#define PG8_STAGE(bufoff, gbase, voff) do { _Pragma("unroll") for (int _i = 0; _i < 2; ++_i) { \
        if ((bufoff) < 4 * HTB) __builtin_amdgcn_global_load_lds((const unsigned*)((const char*)(gbase) + (voff)[_i]), (LAS unsigned*)(lds + (bufoff) + ldsw + _i * 8192), 16, 0, Prog::NT_A); \
        else __builtin_amdgcn_global_load_lds((const unsigned*)((const char*)(gbase) + (voff)[_i]), (LAS unsigned*)(lds + (bufoff) + ldsw + _i * 8192), 16, 0, Prog::NT_B); } } while (0)
#define PG8_LDA(dst, b, h) do { _Pragma("unroll") for (int m = 0; m < 4; ++m) { \
        if constexpr (FP8) { dst[m][0].lo = *(const LAS i32x4v*)(lds + PG8_SA(b, h) + aoff + m * 2048); dst[m][0].hi = *(const LAS i32x4v*)(lds + PG8_SA(b, h) + aoff + m * 2048 + 1024); } \
        else { _Pragma("unroll") for (int k = 0; k < 2; ++k) dst[m][k] = *(const LAS FragT*)(lds + PG8_SA(b, h) + aoff + m * 2048 + k * 1024); } } } while (0)
#define PG8_LDB(dst, b, h) do { _Pragma("unroll") for (int n = 0; n < 2; ++n) { \
        if constexpr (FP8) { dst[n][0].lo = *(const LAS i32x4v*)(lds + PG8_SB(b, h) + boff + n * 2048); dst[n][0].hi = *(const LAS i32x4v*)(lds + PG8_SB(b, h) + boff + n * 2048 + 1024); } \
        else { _Pragma("unroll") for (int k = 0; k < 2; ++k) dst[n][k] = *(const LAS FragT*)(lds + PG8_SB(b, h) + boff + n * 2048 + k * 1024); } } } while (0)
#define PG8_MMA(ai, bj, At, Bt) do { __builtin_amdgcn_s_setprio(1); _Pragma("unroll") for (int m = 0; m < 4; ++m) _Pragma("unroll") for (int n = 0; n < 2; ++n) { \
        if constexpr (FP8) asm volatile("v_mfma_scale_f32_16x16x128_f8f6f4 %0, %1, %2, %0, %3, %4 op_sel_hi:[0,0,0]" : "+v"(acc[ai][bj][m][n]) : "v"(Bt[n][0]), "v"(At[m][0]), "v"(scl_b), "v"(scl_a));   \
        else if constexpr (I8) { _Pragma("unroll") for (int k = 0; k < 2; ++k) acc[ai][bj][m][n] = __builtin_amdgcn_mfma_i32_16x16x64_i8(Bt[n][k], At[m][k], acc[ai][bj][m][n], 0, 0, 0); } \
        else { _Pragma("unroll") for (int k = 0; k < 2; ++k) acc[ai][bj][m][n] = (Prog::F16 ? MFMA_F16(Bt[n][k], At[m][k], acc[ai][bj][m][n]) : MFMA_BF16(Bt[n][k], At[m][k], acc[ai][bj][m][n])); } } \
        __builtin_amdgcn_s_setprio(0); } while (0)
#define PG8_WAIT_V(n) asm volatile("s_waitcnt vmcnt(" #n ")" ::: "memory")
#define PG8_WAIT_L(n) asm volatile("s_waitcnt lgkmcnt(" #n ")" ::: "memory")
#define PG8_BAR __builtin_amdgcn_s_barrier()
#define PG8_SCHED __builtin_amdgcn_sched_barrier(0)
    Unit cur, nxt; int ui = 0;
    if (!P.next(0, cur)) return;
    AccT acc[2][2][4][2];
#pragma unroll
    for (int a = 0; a < 2; ++a)
#pragma unroll
        for (int b = 0; b < 2; ++b)
#pragma unroll
            for (int m = 0; m < 4; ++m)
#pragma unroll
                for (int n = 0; n < 2; ++n) acc[a][b][m][n] = (AccT){0, 0, 0, 0};
    FragT At[4][NF], B0[2][NF], B1[2][NF];
    const int scl_a = Prog::SCALE_A, scl_b = Prog::SCALE_B; (void)scl_a; (void)scl_b;
    const char* cA = cur.A; const char* cB = cur.B;
    const int k0s = MK_KSTAG ? ((int)(blockIdx.x % NXCD) * 2 * MK_KSTAG + (((int)(blockIdx.x / NXCD) / MK_KS2_DIV) % MK_KS2_MOD) * MK_KS2_MUL) * (nt / 16) : 0;
#define PG8_KO(t) ((size_t)(((t) + k0s) & (nt - 1)) * kstep)
#if MK_SP2
    PG8_STAGE(PG8_SB(0, 0), cB + PG8_KO(0), voffB); PG8_STAGE(PG8_SB(0, 1), cB + PG8_KO(0) + hstep, voffB); PG8_STAGE(PG8_SA(0, 0), cA + PG8_KO(0), voffA); PG8_STAGE(PG8_SA(0, 1), cA + PG8_KO(0) + hstep, voffA);
    if (wr == 1) PG8_BAR;
    PG8_WAIT_V(2); PG8_BAR;
    PG8_STAGE(PG8_SB(1, 0), cB + PG8_KO(1), voffB); PG8_STAGE(PG8_SA(1, 0), cA + PG8_KO(1), voffA); PG8_STAGE(PG8_SB(1, 1), cB + hstep + PG8_KO(1), voffB);
    PG8_WAIT_V(6); PG8_BAR;
#else
    PG8_STAGE(PG8_SB(0, 0), cB, voffB); PG8_STAGE(PG8_SA(0, 0), cA, voffA); PG8_STAGE(PG8_SB(0, 1), cB + hstep, voffB); PG8_STAGE(PG8_SA(0, 1), cA + hstep, voffA);
    if (wr == 1) PG8_BAR;
    PG8_WAIT_V(4); PG8_BAR;
    PG8_STAGE(PG8_SB(1, 0), cB + kstep, voffB); PG8_STAGE(PG8_SA(1, 0), cA + kstep, voffA); PG8_STAGE(PG8_SB(1, 1), cB + hstep + kstep, voffB);
    PG8_WAIT_V(6); PG8_BAR;
#endif
    for (;;) {
        const bool has_next = P.next(ui + 1, nxt);
        const char* nA = has_next ? nxt.A : cA; const char* nB = has_next ? nxt.B : cB;
        for (int t = 0; t < nt; t += 2) {
            const bool last = (t == nt - 2);
            if constexpr (MK_PF && Prog::PF) { if (t == nt - 4) P.prefetch(cur, tid, lds + PF_OFF + ldsw / 2); }
            const char* a1 = cA + PG8_KO(t + 1);
            const char* a2 = (last ? nA : cA) + PG8_KO(t + 2); const char* b2 = (last ? nB : cB) + PG8_KO(t + 2);
            const char* a3 = (last ? nA : cA) + PG8_KO(t + 3); const char* b3 = (last ? nB : cB) + PG8_KO(t + 3);
#if MK_SP2
            PG8_LDB(B0, 0, 0); PG8_LDB(B1, 0, 1); PG8_SCHED; PG8_LDA(At, 0, 0); PG8_STAGE(PG8_SA(1, 1), a1 + hstep, voffA);
            PG8_WAIT_V(8); PG8_WAIT_L(0); PG8_BAR; PG8_MMA(0, 0, At, B0); PG8_MMA(0, 1, At, B1); PG8_BAR; PG8_SCHED;
            PG8_LDA(At, 0, 1); PG8_STAGE(PG8_SB(0, 0), b2, voffB); PG8_STAGE(PG8_SB(0, 1), b2 + hstep, voffB); PG8_STAGE(PG8_SA(0, 0), a2, voffA);
            PG8_WAIT_V(8); PG8_WAIT_L(0); PG8_BAR; PG8_MMA(1, 0, At, B0); PG8_MMA(1, 1, At, B1); PG8_BAR; PG8_SCHED;
            PG8_LDB(B0, 1, 0); PG8_LDB(B1, 1, 1); PG8_SCHED; PG8_LDA(At, 1, 0); PG8_STAGE(PG8_SA(0, 1), a2 + hstep, voffA);
            PG8_WAIT_V(8); PG8_WAIT_L(0); PG8_BAR; PG8_MMA(0, 0, At, B0); PG8_MMA(0, 1, At, B1); PG8_BAR; PG8_SCHED;
            PG8_LDA(At, 1, 1); PG8_STAGE(PG8_SB(1, 0), b3, voffB); PG8_STAGE(PG8_SB(1, 1), b3 + hstep, voffB); PG8_STAGE(PG8_SA(1, 0), a3, voffA);
            PG8_WAIT_V(8); PG8_WAIT_L(0); PG8_BAR; PG8_MMA(1, 0, At, B0); PG8_MMA(1, 1, At, B1); PG8_BAR; PG8_SCHED;
#else
            PG8_LDB(B0, 0, 0); PG8_SCHED; PG8_LDA(At, 0, 0); PG8_STAGE(PG8_SA(1, 1), a1 + hstep, voffA);
            PG8_WAIT_L(8); PG8_BAR; PG8_WAIT_L(0); PG8_MMA(0, 0, At, B0); PG8_BAR; PG8_SCHED;
            PG8_LDB(B1, 0, 1); PG8_STAGE(PG8_SB(0, 0), b2, voffB);
            PG8_BAR; PG8_WAIT_L(0); PG8_MMA(0, 1, At, B1); PG8_BAR;
            PG8_LDA(At, 0, 1); PG8_STAGE(PG8_SA(0, 0), a2, voffA);
            PG8_BAR; PG8_WAIT_L(0); PG8_MMA(1, 0, At, B0); PG8_BAR; PG8_SCHED;
            PG8_STAGE(PG8_SB(0, 1), b2 + hstep, voffB);
            PG8_WAIT_V(6); PG8_BAR; PG8_MMA(1, 1, At, B1); PG8_BAR;
            PG8_LDB(B0, 1, 0); PG8_SCHED; PG8_LDA(At, 1, 0); PG8_STAGE(PG8_SA(0, 1), a2 + hstep, voffA);
            PG8_WAIT_L(8); PG8_BAR; PG8_WAIT_L(0); PG8_MMA(0, 0, At, B0); PG8_BAR; PG8_SCHED;
            PG8_LDB(B1, 1, 1); PG8_STAGE(PG8_SB(1, 0), b3, voffB);
            PG8_BAR; PG8_WAIT_L(0); PG8_MMA(0, 1, At, B1); PG8_BAR;
            PG8_LDA(At, 1, 1); PG8_STAGE(PG8_SA(1, 0), a3, voffA);
            PG8_BAR; PG8_WAIT_L(0); PG8_MMA(1, 0, At, B0); PG8_BAR; PG8_SCHED;
            PG8_STAGE(PG8_SB(1, 1), b3 + hstep, voffB);
            PG8_WAIT_V(6); PG8_BAR; PG8_MMA(1, 1, At, B1); PG8_BAR;
#endif
        }
#if MK_ALIGN
        if (wr == 0) PG8_BAR;
#endif
        if constexpr (FP8) asm volatile("s_nop 15\n\ts_nop 15" ::: "memory");
        int z_e = 0; asm volatile("" : "+v"(z_e));
        const int lane_e = (int)__builtin_amdgcn_mbcnt_hi(~0u, __builtin_amdgcn_mbcnt_lo(~0u, (unsigned)z_e)), fr_e = lane_e & 15, fq_e = lane_e >> 4;
#if MK_EPI2
        if (Prog::EPI2) (void)P.epi(acc, cur, wr, wc, fr_e, fq_e);
#endif
        const bool keep = P.epi(acc, cur, wr, wc, fr_e, fq_e);
        if (!has_next) break;
        if (!keep) {
#pragma unroll
            for (int a = 0; a < 2; ++a)
#pragma unroll
                for (int b = 0; b < 2; ++b)
#pragma unroll
                    for (int m = 0; m < 4; ++m)
#pragma unroll
                        for (int n = 0; n < 2; ++n) acc[a][b][m][n] = (AccT){0, 0, 0, 0};
        }
        cur = nxt; cA = nA; cB = nB; ++ui;
#if MK_ALIGN
        if (wr == 1) PG8_BAR;
#endif
    }
    PG8_WAIT_V(0);
#if !MK_ALIGN
    if (wr == 0) PG8_BAR;
#endif
    PG8_BAR;
#undef PG8_SA
#undef PG8_SB
#undef PG8_STAGE
#undef PG8_LDA
#undef PG8_LDB
#undef PG8_MMA
#undef PG8_WAIT_V
#undef PG8_WAIT_L
#undef PG8_BAR
#undef PG8_SCHED
}
}

struct Frame {
    LAS unsigned char* lds;
    int tid, lane, wave, G, bx;
    const float *x, *w_in, *b_gate, *ln_v_g, *ln_v_b, *w_s, *b_s, *conv_w, *conv_b, *w_oa, *w_ob, *w_out, *ln_g, *ln_b;
    float* out;
    bf16_t *Win_t, *Woa_t, *Wob_t, *Wout_t, *Xb, *EW, *GVt, *FIX, *RT, *GBb, *YA, *YB, *MG, *OUTB;
    unsigned char *Wi8, *Xi8; float *SX, *SW;
};

__host__ __device__ __forceinline__ size_t gvt_index(int ch, int t) { return ((((size_t)(t >> 7) * 8 + (ch >> 8)) * 256 + (ch & 255)) << 7) + (t & 127); }

enum { K_EW = 0, K_GVT = 1, K_BU = 2, K_GATE = 4, K_MIDA = 5, K_MRG = 6, K_OUT = 7 };
struct ProgP1 {
    static constexpr bool EPI2 = true, FP8 = false, I8 = true; static constexpr int NT_A = (MK_NT1) & 3, NT_B = ((MK_NT1) >> 2) & 3; static constexpr bool F16 = false; static constexpr bool PF = true;
    static constexpr int SCALE_A = 0, SCALE_B = 0;
    const unsigned char *Xi8, *Wi8; const float *SX, *SW; bf16_t *EW, *GVt, *YB, *FIX, *RT, *GBb; const float *b_gate, *conv_w, *conv_b; LAS unsigned char* hl; int G, c; void* dbg;
    typedef pg8::i32x4v ivec;
    static __device__ __forceinline__ f32x2 ex2v(f32x2 x) { return (f32x2){ex2(x.x), ex2(x.y)}; }
    static __device__ __forceinline__ f32x2 rcpv(f32x2 x) { return (f32x2){rcp(x.x), rcp(x.y)}; }
    static __device__ __forceinline__ f32x2 sig_den2(f32x2 x) { return ex2v(x * (-LOG2E)) + 1.0f; }
    static __device__ __forceinline__ f32x2 gelu_den2(f32x2 x) { return ex2v(x * (x * x * GELU_C3 + GELU_C1)) + 1.0f; }
    static __device__ __forceinline__ f32x4 tof(ivec v) { return (f32x4){(float)v[0], (float)v[1], (float)v[2], (float)v[3]}; }
    __device__ __forceinline__ void prefetch(const pg8::Unit& u, int tid, LAS unsigned char* dump) const {
        if (tid < 64) {
            const int j = tid & 7, g = (tid >> 3) & 3;
            const float* q = g == 0 ? SX + u.pm * 256 + j * 32 : g == 1 ? SW + u.pn * 256 + j * 32 : b_gate + (j >> 2) * D + ((u.pn >= 56 ? u.pn - 56 : 0) * 128) + (j & 3) * 32;
            __builtin_amdgcn_global_load_lds((const unsigned*)q, (LAS unsigned*)dump, 4, 0, 0);
        }
    }
    __device__ __forceinline__ bool next(int i, pg8::Unit& u) const {
        constexpr int NPN = 40 + MK_NBI;
        const long L = (long)i * G + c; if (L >= 64 * NPN) return false;
        int pm, pn; pg8::tile_of((int)L, 64, NPN, pm, pn, MK_WGM1);
        if (MK_PNROT) pn = (pn + (c % 8) * (NPN / 8)) % NPN;
        pn = pn < 16 ? pn + 56 : pn - 16;
        u.pm = pm; u.pn = pn;
        const char* xp = (const char*)Xi8 + (size_t)pm * (256 * 2048); const char* wp = (const char*)Wi8 + (size_t)pn * (256 * 2048);
        if (pn < 16) { u.kind = K_EW; u.A = xp; u.B = wp; }
        else if (pn < 24) { u.kind = K_GVT; u.A = wp; u.B = xp; }
        else if (pn < 56) { u.kind = K_BU; u.A = xp; u.B = wp; }
        else { u.kind = K_GATE; u.A = xp; u.B = wp; }
        return true;
    }
    __device__ __forceinline__ bool epi(const ivec (&acc)[2][2][4][2], const pg8::Unit& u, int wr, int wc, int fr, int fq) const {
        const int rloc = wr * 64 + fr, cloc = wc * 32 + 8 * fq;
        const int kind = u.kind;
        if (kind == K_GVT) {
            bf16_t* base = GVt + ((((size_t)(2 * u.pm) * 8 + (u.pn - 16)) * 256 + rloc) << 7) + cloc;
            f32x4 sxc[2][2];
#pragma unroll
            for (int bj = 0; bj < 2; ++bj)
#pragma unroll
                for (int n = 0; n < 2; ++n) sxc[bj][n] = *(const f32x4*)(SX + u.pm * 256 + bj * 128 + cloc + 4 * n);
            const float* swp = SW + u.pn * 256 + rloc;
#pragma unroll
            for (int ai = 0; ai < 2; ++ai)
#pragma unroll
                for (int m = 0; m < 4; ++m) {
                    const float swr = swp[ai * 128 + m * 16];
#pragma unroll
                    for (int bj = 0; bj < 2; ++bj) {
                        const f32x4 a = tof(acc[ai][bj][m][0]) * sxc[bj][0] * swr, b = tof(acc[ai][bj][m][1]) * sxc[bj][1] * swr;
                        const f32x2 a01 = (f32x2){a[0], a[1]}, a23 = (f32x2){a[2], a[3]}, b01 = (f32x2){b[0], b[1]}, b23 = (f32x2){b[2], b[3]};
                        const f32x2 r0 = a01 * rcpv(gelu_den2(a01)), r1 = a23 * rcpv(gelu_den2(a23)), r2 = b01 * rcpv(gelu_den2(b01)), r3 = b23 * rcpv(gelu_den2(b23));
                        u32x4 w; w.x = ST_PK(r0.x, r0.y); w.y = ST_PK(r1.x, r1.y); w.z = ST_PK(r2.x, r2.y); w.w = ST_PK(r3.x, r3.y);
                        NT_ST((u32x4*)(base + (size_t)bj * (8 * 256 * 128) + (size_t)(ai * 128 + m * 16) * 128), (w));
                    }
                }
            return false;
        }
        f32x4 sw[2][2];
#pragma unroll
        for (int bj = 0; bj < 2; ++bj)
#pragma unroll
            for (int n = 0; n < 2; ++n) sw[bj][n] = *(const f32x4*)(SW + u.pn * 256 + bj * 128 + cloc + 4 * n);
        const float* sxp = SX + u.pm * 256 + rloc;
        if (kind == K_GATE) {
            const int ch = (u.pn - 56) * 128 + cloc;
            f32x4 ba[2], bb[2];
#pragma unroll
            for (int n = 0; n < 2; ++n) { ba[n] = *(const f32x4*)(b_gate + ch + 4 * n); bb[n] = *(const f32x4*)(b_gate + D + ch + 4 * n); }
            const size_t o0 = (size_t)(u.pm * 256 + rloc) * D + ch;
#pragma unroll
            for (int ai = 0; ai < 2; ++ai)
#pragma unroll
                for (int m = 0; m < 4; ++m) {
                    const float sxr = sxp[ai * 128 + m * 16];
                    unsigned w1[4], w2[4];
#pragma unroll
                    for (int n = 0; n < 2; ++n) {
                        const f32x4 va = tof(acc[ai][0][m][n]) * (sw[0][n] * sxr) + ba[n], vb = tof(acc[ai][1][m][n]) * (sw[1][n] * sxr) + bb[n];
#pragma unroll
                        for (int jj = 0; jj < 2; ++jj) {
                            f32x2 xa = (f32x2){va[2 * jj], va[2 * jj + 1]}, xb = (f32x2){vb[2 * jj], vb[2 * jj + 1]};
                            xa.x = fminf(fmaxf(xa.x, -30.f), 30.f); xa.y = fminf(fmaxf(xa.y, -30.f), 30.f); xb.x = fminf(fmaxf(xb.x, -30.f), 30.f); xb.y = fminf(fmaxf(xb.y, -30.f), 30.f);
                            const f32x2 da = sig_den2(xa), db = sig_den2(xb);
                            const f32x2 rt = db * rcpv(da), gb = rcpv(db);
                            w1[2 * n + jj] = cvt_pk_bf16(rt.x, rt.y); w2[2 * n + jj] = cvt_pk_bf16(gb.x, gb.y);
                        }
                    }
#if MK_GFRAG
                    const size_t o = ((((((size_t)u.pm * 16 + (u.pn - 56)) * 2 + ai) * 4 + m) * 8 + (wr * 4 + wc)) * 64 + (fq * 16 + fr)) * 8;
#else
                    const size_t o = o0 + (size_t)(ai * 128 + m * 16) * D;
#endif
                    NT_ST((u32x4*)(RT + o), ((u32x4){w1[0], w1[1], w1[2], w1[3]})); NT_ST((u32x4*)(GBb + o), ((u32x4){w2[0], w2[1], w2[2], w2[3]}));
                }
            return false;
        }
        if (kind == K_EW) {
#if MK_EWFRAG
            bf16_t* base = EW + ((((size_t)(2 * u.pm) * 8 + (u.pn >> 1)) * 8 + 4 * wr) * 8 + ((u.pn & 1) * 4 + wc)) * 512 + (size_t)(fq * 16 + fr) * 8;
#else
            bf16_t* base = EW + (size_t)(u.pm * 256 + rloc) * D + u.pn * 128 + cloc;
#endif
#pragma unroll
            for (int ai = 0; ai < 2; ++ai)
#pragma unroll
                for (int m = 0; m < 4; ++m) {
                    const float sxr = sxp[ai * 128 + m * 16];
                    unsigned w[4];
#pragma unroll
                    for (int n = 0; n < 2; ++n) {
                        const f32x4 va = tof(acc[ai][0][m][n]) * (sw[0][n] * sxr), vb = tof(acc[ai][1][m][n]) * (sw[1][n] * sxr);
#pragma unroll
                        for (int jj = 0; jj < 2; ++jj) {
                            const f32x2 a = (f32x2){va[2 * jj], va[2 * jj + 1]}, b = (f32x2){vb[2 * jj], vb[2 * jj + 1]};
                            const f32x2 r = a * b * rcpv(gelu_den2(a) * sig_den2(b));
                            w[2 * n + jj] = ST_PK(r.x, r.y);
                        }
                    }
#if MK_EWFRAG
                    NT_ST((u32x4*)(base + (size_t)ai * (8 * 8 * 8 * 512) + (size_t)m * (8 * 512)), ((u32x4){w[0], w[1], w[2], w[3]}));
#else
                    NT_ST((u32x4*)(base + (size_t)(ai * 128 + m * 16) * D), ((u32x4){w[0], w[1], w[2], w[3]}));
#endif
                }
            return false;
        }
        epi_bu(acc, u, sw, sxp, wr, wc, fr, fq);
        return false;
    }
    __device__ __forceinline__ void epi_bu(const ivec (&acc)[2][2][4][2], const pg8::Unit& u, const f32x4 (&sw)[2][2], const float* sxp, int wr, int wc, int fr, int fq) const {
        const int ub = u.pn - 24, cu = 16 * wc + 4 * fq, ch = 64 * ub + cu;
        const f32x4 w0 = *(const f32x4*)(conv_w + ch), w1 = *(const f32x4*)(conv_w + D + ch), w2 = *(const f32x4*)(conv_w + 2 * D + ch), cb = *(const f32x4*)(conv_b + ch);
        bf16_t* HALO = FIX; bf16_t* H01 = FIX + 64 * 2 * D; bf16_t* G01 = FIX + 2 * 64 * 2 * D;
        LAS unsigned char* hrow = hl + (64 * wr + fr) * HL_PITCH + cu * 2;
#pragma unroll
        for (int ai = 0; ai < 2; ++ai) {
            u32x2 hw[4]; f32x4 gg[4];
#pragma unroll
            for (int m = 0; m < 4; ++m) {
                const float sxr = sxp[ai * 128 + m * 16];
                const f32x4 x = tof(acc[ai][0][m][0]) * (sw[0][0] * sxr), c = tof(acc[ai][0][m][1]) * (sw[0][1] * sxr), b = tof(acc[ai][1][m][0]) * (sw[1][0] * sxr), z = tof(acc[ai][1][m][1]) * (sw[1][1] * sxr);
                const f32x4 h = x * c;
                hw[m] = (u32x2){ST_PK(h[0], h[1]), ST_PK(h[2], h[3])};
                const f32x2 d01 = sig_den2((f32x2){z[0], z[1]}), d23 = sig_den2((f32x2){z[2], z[3]});
                const f32x2 g01 = (f32x2){b[0], b[1]} * (f32x2){z[0], z[1]} * rcpv(d01), g23 = (f32x2){b[2], b[3]} * (f32x2){z[2], z[3]} * rcpv(d23);
                const u32x2 gw = (u32x2){ST_PK(g01.x, g01.y), ST_PK(g23.x, g23.y)};
                gg[m] = (f32x4){ST_LO(gw.x), ST_HI(gw.x), ST_LO(gw.y), ST_HI(gw.y)};
                *(LAS u32x2*)(hrow + (2 + 16 * m) * HL_PITCH) = hw[m];
                if (ai == 0 && wr == 0 && m == 0 && fr < 2) {
                    *(u32x2*)(H01 + ((size_t)u.pm * 2 + fr) * D + ch) = hw[m]; *(u32x2*)(G01 + ((size_t)u.pm * 2 + fr) * D + ch) = gw; }
                if (ai == 1 && wr == 1 && m == 3 && fr >= 14) *(u32x2*)(HALO + ((size_t)u.pm * 2 + (fr - 14)) * D + ch) = hw[m];
            }
            if (ai == 1 && wr == 1 && fr >= 14) {
                const float sxr = sxp[48];
                const f32x4 h = (tof(acc[0][0][3][0]) * (sw[0][0] * sxr)) * (tof(acc[0][0][3][1]) * (sw[0][1] * sxr));
                *(LAS u32x2*)(hl + (fr - 14) * HL_PITCH + cu * 2) = (u32x2){ST_PK(h[0], h[1]), ST_PK(h[2], h[3])};
            }
            LDS_BARRIER();
            bf16_t* yrow = YB + (size_t)(u.pm * 256 + ai * 128 + 64 * wr + fr) * D + ch;
#pragma unroll
            for (int m = 0; m < 4; ++m) {
                const u32x2 a1 = *(const LAS u32x2*)(hrow + (1 + 16 * m) * HL_PITCH), a2 = *(const LAS u32x2*)(hrow + (16 * m) * HL_PITCH);
                const f32x4 h0 = (f32x4){ST_LO(hw[m].x), ST_HI(hw[m].x), ST_LO(hw[m].y), ST_HI(hw[m].y)};
                const f32x4 h1 = (f32x4){ST_LO(a1.x), ST_HI(a1.x), ST_LO(a1.y), ST_HI(a1.y)}, h2 = (f32x4){ST_LO(a2.x), ST_HI(a2.x), ST_LO(a2.y), ST_HI(a2.y)};
                const f32x4 y = gg[m] * (cb + w0 * h2 + w1 * h1 + w2 * h0);
                NT_ST((u32x2*)(yrow + (size_t)(16 * m) * D), ((u32x2){OP_PK(y[0], y[1]), OP_PK(y[2], y[3])}));
            }
            LDS_BARRIER();
        }
    }
};

struct ProgP1B {
    static constexpr bool EPI2 = false, FP8 = false, I8 = false; static constexpr int SCALE_A = 0, SCALE_B = 0; static constexpr void* dbg = nullptr; static constexpr int NT_A = (MK_NT1B) & 3, NT_B = ((MK_NT1B) >> 2) & 3; static constexpr bool F16 = (MK_F16S != 0); static constexpr bool PF = false;
    const bf16_t *Xb, *Wbf; bf16_t *YB, *FIX; const float *conv_w, *conv_b; LAS unsigned char* hl; int G, c;
    static __device__ __forceinline__ f32x2 ex2v(f32x2 x) { return (f32x2){ex2(x.x), ex2(x.y)}; }
    static __device__ __forceinline__ f32x2 rcpv(f32x2 x) { return (f32x2){rcp(x.x), rcp(x.y)}; }
    static __device__ __forceinline__ f32x2 sig_den2(f32x2 x) { return ex2v(x * (-LOG2E)) + 1.0f; }
    __device__ __forceinline__ bool next(int i, pg8::Unit& u) const {
        constexpr int NB = 32 - MK_NBI;
        const long L = (long)i * G + c; if (L >= 64 * NB) return false;
        int pm, pn; pg8::tile_of((int)L, 64, NB, pm, pn, MK_WGM1B); if (MK_PNROT) pn = (pn + (c % 8) * (NB / 8)) % NB; u.pm = pm; u.pn = 24 + MK_NBI + pn; u.kind = K_BU;
        u.A = (const char*)Xb + (size_t)pm * (256 * 2048 * 2); u.B = (const char*)Wbf + (size_t)(MK_NBI + pn) * (256 * 2048 * 2);
        return true;
    }
    __device__ __forceinline__ bool epi(const f32x4 (&acc)[2][2][4][2], const pg8::Unit& u, int wr, int wc, int fr, int fq) const {
        const int ub = u.pn - 24, cu = 16 * wc + 4 * fq, ch = 64 * ub + cu;
        const f32x4 w0 = *(const f32x4*)(conv_w + ch), w1 = *(const f32x4*)(conv_w + D + ch), w2 = *(const f32x4*)(conv_w + 2 * D + ch), cb = *(const f32x4*)(conv_b + ch);
        bf16_t* HALO = FIX; bf16_t* H01 = FIX + 64 * 2 * D; bf16_t* G01 = FIX + 2 * 64 * 2 * D;
        LAS unsigned char* hrow = hl + (64 * wr + fr) * HL_PITCH + cu * 2;
#pragma unroll
        for (int ai = 0; ai < 2; ++ai) {
            u32x2 hw[4]; f32x4 gg[4];
#pragma unroll
            for (int m = 0; m < 4; ++m) {
                const f32x4 x = acc[ai][0][m][0], c = acc[ai][0][m][1], b = acc[ai][1][m][0], z = acc[ai][1][m][1];
                const f32x4 h = x * c;
                hw[m] = (u32x2){ST_PK(h[0], h[1]), ST_PK(h[2], h[3])};
                const f32x2 d01 = sig_den2((f32x2){z[0], z[1]}), d23 = sig_den2((f32x2){z[2], z[3]});
                const f32x2 g01 = (f32x2){b[0], b[1]} * (f32x2){z[0], z[1]} * rcpv(d01), g23 = (f32x2){b[2], b[3]} * (f32x2){z[2], z[3]} * rcpv(d23);
                const u32x2 gw = (u32x2){ST_PK(g01.x, g01.y), ST_PK(g23.x, g23.y)};
                gg[m] = (f32x4){ST_LO(gw.x), ST_HI(gw.x), ST_LO(gw.y), ST_HI(gw.y)};
                *(LAS u32x2*)(hrow + (2 + 16 * m) * HL_PITCH) = hw[m];
                if (ai == 0 && wr == 0 && m == 0 && fr < 2) { *(u32x2*)(H01 + ((size_t)u.pm * 2 + fr) * D + ch) = hw[m]; *(u32x2*)(G01 + ((size_t)u.pm * 2 + fr) * D + ch) = gw; }
                if (ai == 1 && wr == 1 && m == 3 && fr >= 14) *(u32x2*)(HALO + ((size_t)u.pm * 2 + (fr - 14)) * D + ch) = hw[m];
            }
            if (ai == 1 && wr == 1 && fr >= 14) {
                const f32x4 h = acc[0][0][3][0] * acc[0][0][3][1];
                *(LAS u32x2*)(hl + (fr - 14) * HL_PITCH + cu * 2) = (u32x2){ST_PK(h[0], h[1]), ST_PK(h[2], h[3])};
            }
            LDS_BARRIER();
            bf16_t* yrow = YB + (size_t)(u.pm * 256 + ai * 128 + 64 * wr + fr) * D + ch;
#pragma unroll
            for (int m = 0; m < 4; ++m) {
                const u32x2 a1 = *(const LAS u32x2*)(hrow + (1 + 16 * m) * HL_PITCH), a2 = *(const LAS u32x2*)(hrow + (16 * m) * HL_PITCH);
                const f32x4 h0 = (f32x4){ST_LO(hw[m].x), ST_HI(hw[m].x), ST_LO(hw[m].y), ST_HI(hw[m].y)};
                const f32x4 h1 = (f32x4){ST_LO(a1.x), ST_HI(a1.x), ST_LO(a1.y), ST_HI(a1.y)}, h2 = (f32x4){ST_LO(a2.x), ST_HI(a2.x), ST_LO(a2.y), ST_HI(a2.y)};
                const f32x4 y = gg[m] * (cb + w0 * h2 + w1 * h1 + w2 * h0);
                NT_ST((u32x2*)(yrow + (size_t)(16 * m) * D), ((u32x2){OP_PK(y[0], y[1]), OP_PK(y[2], y[3])}));
            }
            LDS_BARRIER();
        }
        return false;
    }
};

struct ProgP3 {
    static constexpr bool EPI2 = false, FP8 = false, I8 = false; static constexpr int SCALE_A = 0, SCALE_B = 0; static constexpr void* dbg = nullptr; static constexpr int NT_A = (MK_NT3) & 3, NT_B = ((MK_NT3) >> 2) & 3; static constexpr bool F16 = (MK_F16M != 0); static constexpr bool PF = true;
    const bf16_t *YA, *YB, *Woa_t, *Wob_t, *RT, *GBb; bf16_t* MG; int G, c;
    __device__ __forceinline__ void prefetch(const pg8::Unit& u, int tid, LAS unsigned char* dump) const {
        const char* b = (const char*)(u.kind == K_MIDA ? RT : GBb) + (size_t)(u.pm * 256) * (D * 2) + (size_t)u.pn * 512;
        __builtin_amdgcn_global_load_lds((const unsigned*)(b + (size_t)(tid >> 2) * (D * 2) + (tid & 3) * 128), (LAS unsigned*)dump, 4, 0, 0);
        __builtin_amdgcn_global_load_lds((const unsigned*)(b + (size_t)(128 + (tid >> 2)) * (D * 2) + (tid & 3) * 128), (LAS unsigned*)(dump + 256), 4, 0, 0);
    }
    __device__ __forceinline__ bool next(int i, pg8::Unit& u) const {
        const long L = (long)(i >> 1) * G + c; if (L >= 64 * 8) return false;
        int pm, pn; pg8::tile_of((int)L, 64, 8, pm, pn, MK_WGM3); u.pm = pm; u.pn = pn;
        const size_t ao = (size_t)pm * (256 * 2048 * 2), bo = (size_t)pn * (256 * 2048 * 2);
        if ((i & 1) == 0) { u.kind = K_MIDA; u.A = (const char*)YA + ao; u.B = (const char*)Woa_t + bo; }
        else { u.kind = K_MRG; u.A = (const char*)YB + ao; u.B = (const char*)Wob_t + bo; }
        return true;
    }
    __device__ __forceinline__ bool epi(f32x4 (&acc)[2][2][4][2], const pg8::Unit& u, int wr, int wc, int fr, int fq) const {
        const size_t o0 = (size_t)(u.pm * 256 + wr * 64 + fr) * D + u.pn * 256 + wc * 32 + 8 * fq;
        if (u.kind == K_MIDA) {
#pragma unroll
            for (int ai = 0; ai < 2; ++ai)
#pragma unroll
                for (int m = 0; m < 4; ++m)
#pragma unroll
                    for (int bj = 0; bj < 2; ++bj) {
                        const u32x4 r = *(const u32x4*)(RT + (MK_GFRAG ? ((((((size_t)u.pm * 16 + (2 * u.pn + bj)) * 2 + ai) * 4 + m) * 8 + (wr * 4 + wc)) * 64 + (fq * 16 + fr)) * 8 : o0 + (size_t)(ai * 128 + m * 16) * D + bj * 128));
                        acc[ai][bj][m][0][0] *= bf_lo(r.x); acc[ai][bj][m][0][1] *= bf_hi(r.x); acc[ai][bj][m][0][2] *= bf_lo(r.y); acc[ai][bj][m][0][3] *= bf_hi(r.y);
                        acc[ai][bj][m][1][0] *= bf_lo(r.z); acc[ai][bj][m][1][1] *= bf_hi(r.z); acc[ai][bj][m][1][2] *= bf_lo(r.w); acc[ai][bj][m][1][3] *= bf_hi(r.w);
                    }
            return true;
        }
#pragma unroll
        for (int ai = 0; ai < 2; ++ai)
#pragma unroll
            for (int m = 0; m < 4; ++m)
#pragma unroll
                for (int bj = 0; bj < 2; ++bj) {
                    const size_t o = o0 + (size_t)(ai * 128 + m * 16) * D + bj * 128;
                    const u32x4 g = *(const u32x4*)(GBb + (MK_GFRAG ? ((((((size_t)u.pm * 16 + (2 * u.pn + bj)) * 2 + ai) * 4 + m) * 8 + (wr * 4 + wc)) * 64 + (fq * 16 + fr)) * 8 : o));
                    const f32x4 a = acc[ai][bj][m][0], b = acc[ai][bj][m][1];
                    u32x4 w;
                    w.x = OP_PK(a[0] * bf_lo(g.x), a[1] * bf_hi(g.x)); w.y = OP_PK(a[2] * bf_lo(g.y), a[3] * bf_hi(g.y));
                    w.z = OP_PK(b[0] * bf_lo(g.z), b[1] * bf_hi(g.z)); w.w = OP_PK(b[2] * bf_lo(g.w), b[3] * bf_hi(g.w));
                    *(u32x4*)(MG + o) = w;
                }
        return false;
    }
};

struct ProgP4 {
    static constexpr bool EPI2 = false, FP8 = false, I8 = false; static constexpr int SCALE_A = 0, SCALE_B = 0; static constexpr void* dbg = nullptr; static constexpr int NT_A = (MK_NT4) & 3, NT_B = ((MK_NT4) >> 2) & 3; static constexpr bool F16 = (MK_F16M != 0); static constexpr bool PF = false;
    const bf16_t *MG, *Wout_t; bf16_t* OUTB; int G, c;
    __device__ __forceinline__ bool next(int i, pg8::Unit& u) const {
        const int nr = (64 * 8 + G - 1) / G;
        if (i >= nr) return false;
        const long L = (long)((MK_P4REV && (64 * 8) % G == 0) ? nr - 1 - i : i) * G + c; if (L >= 64 * 8) return false;
        int pm, pn; pg8::tile_of((int)L, 64, 8, pm, pn, MK_WGM4); u.pm = pm; u.pn = pn; u.kind = K_OUT;
        u.A = (const char*)MG + (size_t)pm * (256 * 2048 * 2); u.B = (const char*)Wout_t + (size_t)pn * (256 * 2048 * 2);
        return true;
    }
    __device__ __forceinline__ bool epi(const f32x4 (&acc)[2][2][4][2], const pg8::Unit& u, int wr, int wc, int fr, int fq) const {
        bf16_t* base = OUTB + (size_t)(u.pm * 256 + wr * 64 + fr) * D + u.pn * 256 + wc * 32 + 8 * fq;
#pragma unroll
        for (int ai = 0; ai < 2; ++ai)
#pragma unroll
            for (int m = 0; m < 4; ++m)
#pragma unroll
                for (int bj = 0; bj < 2; ++bj) {
                    const f32x4 a = acc[ai][bj][m][0], b = acc[ai][bj][m][1];
                    u32x4 w; w.x = ST_PK(a[0], a[1]); w.y = ST_PK(a[2], a[3]); w.z = ST_PK(b[0], b[1]); w.w = ST_PK(b[2], b[3]);
                    *(u32x4*)(base + (size_t)(ai * 128 + m * 16) * D + bj * 128) = w;
                }
        return false;
    }
};

__device__ __forceinline__ unsigned f2bf(float f) { unsigned u = __builtin_bit_cast(unsigned, f); return (u + 0x7fffu + ((u >> 16) & 1u)) >> 16; }
__device__ __forceinline__ unsigned pk2(float lo, float hi) { return f2bf(lo) | (f2bf(hi) << 16); }
__device__ __forceinline__ int win_row(int n) {
    const int seg = n >> 11, ch = n & 2047, pr = ((ch >> 7) << 8) + (ch & 127);
    if (seg >= 3 && seg <= 6) {
        const int q = seg - 3, cu = ch & 63;
        return 6144 + 256 * (ch >> 6) + 128 * (q >> 1) + 32 * (cu >> 4) + 8 * ((cu >> 2) & 3) + 4 * (q & 1) + (cu & 3);
    }
    switch (seg) {
        case 0: return pr;            case 2: return pr + 128;
        case 1: return 4096 + ch;
        case 7: return 14336 + pr;    default: return 14336 + pr + 128;
    }
}
__device__ __forceinline__ unsigned pk4_i8(float a, float b, float c, float d) {
    const int q0 = (int)__builtin_rintf(a), q1 = (int)__builtin_rintf(b), q2 = (int)__builtin_rintf(c), q3 = (int)__builtin_rintf(d);
    return ((unsigned)q0 & 255u) | (((unsigned)q1 & 255u) << 8) | (((unsigned)q2 & 255u) << 16) | ((unsigned)q3 << 24);
}
template <bool MAP> __device__ __forceinline__ void p0_transpose_item(const float* W, int K, int N, bf16_t* WT, LAS float* scr, int kb, int nb, int lane) {
    const int k0 = 64 * kb, n0 = 32 * nb;
    float wv[32];
#pragma unroll
    for (int i = 0; i < 32; ++i) wv[i] = W[(size_t)(k0 + 2 * i + (lane >> 5)) * N + n0 + (lane & 31)];
#pragma unroll
    for (int i = 0; i < 32; ++i) scr[(2 * i + (lane >> 5)) * 33 + (lane & 31)] = wv[i];
    LDS_WAIT(); asm volatile("" ::: "memory");
    const int c = lane & 7;
#pragma unroll
    for (int j = 0; j < 4; ++j) { const int n = (lane >> 3) + 8 * j; const LAS float* s = scr + (8 * c) * 33 + n;
        const int rown = MAP ? win_row(n0 + n) : n0 + n;
        u32x4 o;
        if (MAP) { o.x = ST_PK(s[0 * 33], s[1 * 33]); o.y = ST_PK(s[2 * 33], s[3 * 33]); o.z = ST_PK(s[4 * 33], s[5 * 33]); o.w = ST_PK(s[6 * 33], s[7 * 33]); }
        else { o.x = OP_PK(s[0 * 33], s[1 * 33]); o.y = OP_PK(s[2 * 33], s[3 * 33]); o.z = OP_PK(s[4 * 33], s[5 * 33]); o.w = OP_PK(s[6 * 33], s[7 * 33]); }
        *(u32x4*)(WT + (size_t)rown * K + k0 + 8 * c) = o; }
    LDS_WAIT(); asm volatile("" ::: "memory");
}
constexpr int Q_KB = 68, Q_CP = 2180;
__device__ __forceinline__ void p0_quant_load(const Frame& F, int n0, int tid, f32x4 (&v)[16]) {
    const int c4 = tid & 3, r = tid >> 2;
    const float* wp = F.w_in + (size_t)r * NC + n0 + 4 * c4;
#pragma unroll
    for (int i = 0; i < 16; ++i) v[i] = *(const f32x4*)(wp + (size_t)(128 * i) * NC);
}
__device__ __forceinline__ void p0_quant_stage(const Frame& F, int tid, const f32x4 (&v)[16]) {
    LAS float* T = (LAS float*)F.lds;
    const int c4 = tid & 3, r = tid >> 2;
#pragma unroll
    for (int i = 0; i < 16; ++i) { const int k = r + 128 * i; LAS float* d = T + (4 * c4) * Q_CP + (k >> 6) * Q_KB + (k & 63);
        d[0] = v[i][0]; d[Q_CP] = v[i][1]; d[2 * Q_CP] = v[i][2]; d[3 * Q_CP] = v[i][3]; }
}
__device__ __forceinline__ void p0_quant_emit(const Frame& F, int n0, int tid) {
    const LAS float* T = (const LAS float*)F.lds;
    const int c = tid >> 5, kb = tid & 31;
    const LAS f32x4* src = (const LAS f32x4*)(T + c * Q_CP + kb * Q_KB);
    f32x4 v[16];
#pragma unroll
    for (int q = 0; q < 16; ++q) v[q] = src[q];
    f32x4 m4 = (f32x4){0.f, 0.f, 0.f, 0.f};
#pragma unroll
    for (int q = 0; q < 16; ++q) m4 = __builtin_elementwise_max(m4, __builtin_elementwise_abs(v[q]));
    float mx = fmaxf(fmaxf(m4[0], m4[1]), fmaxf(m4[2], m4[3]));
#pragma unroll
    for (int o = 1; o < 32; o <<= 1) mx = fmaxf(mx, __shfl_xor(mx, o));
    const float inv = mx > 0.f ? 127.f / mx : 0.f;
    const int row = win_row(n0 + c);
    if (kb == 0) F.SW[row] = mx > 0.f ? mx * (1.f / 127.f) : 1.f;
    unsigned d[16];
#pragma unroll
    for (int q = 0; q < 16; ++q) d[q] = pk4_i8(v[q][0] * inv, v[q][1] * inv, v[q][2] * inv, v[q][3] * inv);
    unsigned char* dst = F.Wi8 + (size_t)row * D + 64 * kb;
#pragma unroll
    for (int q = 0; q < 4; ++q) *(u32x4*)(dst + 16 * q) = (u32x4){d[4 * q], d[4 * q + 1], d[4 * q + 2], d[4 * q + 3]};
}
__device__ __forceinline__ void p0_xrow_emit(Frame& F, int row, int lane, const f32x4 (&v)[8]) {
    float mx = 0.f;
#pragma unroll
    for (int j = 0; j < 8; ++j) mx = fmaxf(fmaxf(mx, fmaxf(fabsf(v[j][0]), fabsf(v[j][1]))), fmaxf(fabsf(v[j][2]), fabsf(v[j][3])));
#pragma unroll
    for (int o = 1; o < 64; o <<= 1) mx = fmaxf(mx, __shfl_xor(mx, o));
    const float inv = mx > 0.f ? 127.f / mx : 0.f;
    if (lane == 0) F.SX[row] = mx > 0.f ? mx * (1.f / 127.f) : 1.f;
    unsigned char* xq = F.Xi8 + (size_t)row * D + 4 * lane;
#pragma unroll
    for (int j = 0; j < 8; ++j) *(unsigned*)(xq + 256 * j) = pk4_i8(v[j][0] * inv, v[j][1] * inv, v[j][2] * inv, v[j][3] * inv);
    if (MK_NBI < 32) {
        bf16_t* xb = F.Xb + (size_t)row * D + 4 * lane;
#pragma unroll
        for (int j = 0; j < 8; ++j) *(u32x2*)(xb + 256 * j) = (u32x2){ST_PK(v[j][0], v[j][1]), ST_PK(v[j][2], v[j][3])};
    }
}
__device__ __forceinline__ void p0_xrows(Frame& F, int gw, int NGW, int lane) {
    for (int row = gw; row < M; row += 2 * NGW) {
        const int row2 = row + NGW;
        const float* xp = F.x + (size_t)row * D + 4 * lane; const float* xp2 = F.x + (size_t)(row2 < M ? row2 : row) * D + 4 * lane;
        f32x4 v[8], w[8];
#pragma unroll
        for (int j = 0; j < 8; ++j) { v[j] = *(const f32x4*)(xp + 256 * j); w[j] = *(const f32x4*)(xp2 + 256 * j); }
        p0_xrow_emit(F, row, lane, v);
        if (row2 < M) p0_xrow_emit(F, row2, lane, w);
    }
}
constexpr int P0_ROWS_PER_QITEM = 16;
__device__ __forceinline__ void p0_xrows_range(Frame& F, int start, int nrows, int wave, int lane) {
    for (int k = wave; k < nrows; k += 16) {
        const int row = start + k, row2 = row + 8; const bool two = (k + 8) < nrows;
        const float* xp = F.x + (size_t)row * D + 4 * lane; const float* xp2 = F.x + (size_t)(two ? row2 : row) * D + 4 * lane;
        f32x4 v[8], w[8];
#pragma unroll
        for (int j = 0; j < 8; ++j) { v[j] = *(const f32x4*)(xp + 256 * j); w[j] = *(const f32x4*)(xp2 + 256 * j); }
        p0_xrow_emit(F, row, lane, v);
        if (two) p0_xrow_emit(F, row2, lane, w);
    }
}
template <int PART> __device__ __forceinline__ void p0_prologue(Frame& F) {
    constexpr int NCH16 = 4 * MK_NBI;
    constexpr int NQ = 384 + 4 * NCH16 + 256;
    auto grp = [&](int it0) -> int {
        const int it = MK_QPAIR ? (it0 & ~255) + 2 * (8 * (((it0 & 255) >> 3) >> 1) + (it0 & 7)) + (((it0 & 255) >> 3) & 1) : it0;
        if (it < 384) return it;
        if (it < 384 + 4 * NCH16) { const int q = it - 384; return 384 + (q / (NCH16 ? NCH16 : 1)) * 128 + q % (NCH16 ? NCH16 : 1); }
        return 896 + (it - 384 - 4 * NCH16); };
    if ((PART & 1) && F.bx < NQ) {
        f32x4 v[16];
        p0_quant_load(F, 16 * grp(F.bx), F.tid, v);
        for (int it = F.bx; it < NQ; it += F.G) {
            p0_quant_stage(F, F.tid, v);
            __syncthreads();
            if (it + F.G < NQ) p0_quant_load(F, 16 * grp(it + F.G), F.tid, v);
            p0_quant_emit(F, 16 * grp(it), F.tid);
            __syncthreads();
        }
    }
    LAS float* scr = (LAS float*)(F.lds + F.wave * 16384);
    const int gw = F.bx * 8 + F.wave, NGW = F.G * 8;
    constexpr int NB32 = 2 * (32 - MK_NBI);
    constexpr int I_BF = (D / 64) * 4 * NB32, I_SQ = (D / 64) * (D / 32);
    if (PART & 2) for (int it = gw; it < I_BF + 3 * I_SQ; it += NGW) {
        int r = it;
        if (r < I_BF) { const int kb = r / (4 * NB32), q = r % (4 * NB32), nb = 192 + (q / NB32) * 64 + 2 * MK_NBI + q % NB32;
            p0_transpose_item<true>(F.w_in, D, NC, F.Win_t - (size_t)6144 * D, scr, kb, nb, F.lane); continue; } r -= I_BF;
        if (r < I_SQ) { p0_transpose_item<false>(F.w_oa, D, D, F.Woa_t, scr, r / (D / 32), r % (D / 32), F.lane); continue; } r -= I_SQ;
        if (r < I_SQ) { p0_transpose_item<false>(F.w_ob, D, D, F.Wob_t, scr, r / (D / 32), r % (D / 32), F.lane); continue; } r -= I_SQ;
        p0_transpose_item<false>(F.w_out, D, D, F.Wout_t, scr, r / (D / 32), r % (D / 32), F.lane);
    }
    if (PART & 4) {
        const int rem = NQ % F.G, tot = M + P0_ROWS_PER_QITEM * rem;
        if (MK_P0BAL && rem != 0 && tot % F.G == 0 && tot / F.G > P0_ROWS_PER_QITEM) {
            const int hi = tot / F.G, lo = hi - P0_ROWS_PER_QITEM;
            const int start = F.bx < rem ? F.bx * lo : rem * lo + (F.bx - rem) * hi;
            p0_xrows_range(F, start, F.bx < rem ? lo : hi, F.wave, F.lane);
        } else p0_xrows(F, gw, NGW, F.lane);
    }
}

constexpr int P2_PITCH = 272;
constexpr int P2_BIMG = 0, P2_WIMG = 256 * P2_PITCH, P2_PART = P2_WIMG + 128 * P2_PITCH, P2_TAB = P2_PART + 16384;
__device__ __forceinline__ void p2_sgu(Frame& F) {
    LAS unsigned char* lds = F.lds;
    int tid = threadIdx.x; asm volatile("" : "+v"(tid));
    const int lane = tid & 63, w = __builtin_amdgcn_readfirstlane(tid >> 6), fr = lane & 15, fq = lane >> 4;
    const int rg = tid >> 4, ck = tid & 15;
    const unsigned gvoff = (unsigned)(rg * 128 + ck * 8) * 2u;
    const unsigned evoff = (unsigned)(fr * D + 32 * w + 8 * fq) * 2u;
    const unsigned wvoff = (unsigned)(rg * 128 + ck * 8) * 4u;
    int hprev = -1;
    u32x4 gvr[8];
    const int p2G = MK_P2HALF ? F.G / 2 : F.G, p2b = (MK_P2HALF && F.bx >= p2G) ? 1024 : F.bx;
    if (p2b < 1024) {
        unsigned gvo = gvoff; asm volatile("" : "+v"(gvo));
        const char* gbase = (const char*)F.GVt + (size_t)((p2b >> 3) * 8 + (p2b & 7)) * 65536;
#pragma unroll
        for (int i = 0; i < 8; ++i) gvr[i] = *(const u32x4*)(gbase + (size_t)i * (32 * 128 * 2) + gvo);
    }
    for (int it = p2b; it < 1024; it += p2G) {
        const int h = it & 7, c = it >> 3;
        unsigned gvo = gvoff, evo = evoff, wvo = wvoff;
        asm volatile("" : "+v"(gvo), "+v"(evo), "+v"(wvo));
#if MK_EWFRAG
        const char* ebase = (const char*)F.EW + ((((size_t)c * 8 + h) * 8) * 8 + w) * 1024 + (size_t)lane * 16;
#else
        const char* ebase = (const char*)F.EW + ((size_t)(c * 128) * D + h * 256) * 2;
#endif
        char* ybase = (char*)F.YA + ((size_t)(c * 128) * D + h * 256) * 2;
        u32x4 ew[8];
#pragma unroll
#if MK_EWFRAG
        for (int m = 0; m < 8; ++m) ew[m] = *(const u32x4*)(ebase + (size_t)m * (8 * 1024));
#else
        for (int m = 0; m < 8; ++m) ew[m] = *(const u32x4*)(ebase + (size_t)m * (16 * D * 2) + evo);
#endif
        LDS_BARRIER();
        if (h != hprev) {
            hprev = h;
            {
                LAS float* tab = (LAS float*)(lds + P2_TAB);
                if (tid < 256) { tab[tid] = F.ln_v_g[h * 256 + tid]; tab[256 + tid] = F.ln_v_b[h * 256 + tid]; }
                else if (tid < 384) tab[512 + (tid - 256)] = F.b_s[h * 128 + (tid - 256)];
            }
            const char* wbase = (const char*)F.w_s + (size_t)h * (128 * 128 * 4);
#pragma unroll
            for (int e = 0; e < 4; ++e) {
                const int t = rg + 32 * e;
                const f32x4 a = *(const f32x4*)(wbase + (size_t)e * (32 * 128 * 4) + wvo), b = *(const f32x4*)(wbase + (size_t)e * (32 * 128 * 4) + 16 + wvo);
                float v[8] = {a[0], a[1], a[2], a[3], b[0], b[1], b[2], b[3]};
#pragma unroll
                for (int j = 0; j < 8; ++j) v[j] = (ck * 8 + j <= t) ? v[j] : 0.f;
                u32x4 o; o.x = ST_PK(v[0], v[1]); o.y = ST_PK(v[2], v[3]); o.z = ST_PK(v[4], v[5]); o.w = ST_PK(v[6], v[7]);
                *(LAS u32x4*)(lds + P2_WIMG + (rg * P2_PITCH + (ck << 4)) + e * (32 * P2_PITCH)) = o;
            }
        }
        float sm[8], sq[8];
#pragma unroll
        for (int j = 0; j < 8; ++j) { sm[j] = 0.f; sq[j] = 0.f; }
#pragma unroll
        for (int i = 0; i < 8; ++i) {
            const unsigned ww[4] = {gvr[i].x, gvr[i].y, gvr[i].z, gvr[i].w};
#pragma unroll
            for (int p = 0; p < 4; ++p) { const float lo = ST_LO(ww[p]), hi = ST_HI(ww[p]); sm[2 * p] += lo; sq[2 * p] += lo * lo; sm[2 * p + 1] += hi; sq[2 * p + 1] += hi * hi; }
        }
#pragma unroll
        for (int j = 0; j < 8; ++j) { sm[j] += __shfl_xor(sm[j], 16); sm[j] += __shfl_xor(sm[j], 32); sq[j] += __shfl_xor(sq[j], 16); sq[j] += __shfl_xor(sq[j], 32); }
        if (lane < 16) {
            LAS f32x4* pp = (LAS f32x4*)(lds + P2_PART + (w * 128 + ck * 8) * 8);
#pragma unroll
            for (int j = 0; j < 4; ++j) pp[j] = (f32x4){sm[2 * j], sq[2 * j], sm[2 * j + 1], sq[2 * j + 1]};
        }
        LDS_BARRIER();
        if (tid < 128) {
            float s1 = 0.f, s2 = 0.f;
#pragma unroll
            for (int ww = 0; ww < 8; ++ww) { const f32x2 v = *(const LAS f32x2*)(lds + P2_PART + tid * 8 + ww * (128 * 8)); s1 += v.x; s2 += v.y; }
            const float mean = s1 * (1.f / 256.f), var = s2 * (1.f / 256.f) - mean * mean;
            *(LAS f32x2*)(lds + P2_PART + 8192 + tid * 8) = (f32x2){mean, rsqrtf(fmaxf(var, 0.f) + LN_EPS)};
        }
        LDS_BARRIER();
        float mu[8], rs[8];
        {
            const LAS f32x4* pp = (const LAS f32x4*)(lds + P2_PART + 8192 + (ck * 8) * 8);
#pragma unroll
            for (int j = 0; j < 4; ++j) { const f32x4 v = pp[j]; mu[2 * j] = v[0]; rs[2 * j] = v[1]; mu[2 * j + 1] = v[2]; rs[2 * j + 1] = v[3]; }
        }
        float nmr[8];
#pragma unroll
        for (int j = 0; j < 8; ++j) nmr[j] = -mu[j] * rs[j];
#pragma unroll
        for (int i = 0; i < 8; ++i) {
            const float g = ((const LAS float*)(lds + P2_TAB))[rg + 32 * i], b = ((const LAS float*)(lds + P2_TAB))[256 + rg + 32 * i];
            const unsigned ww[4] = {gvr[i].x, gvr[i].y, gvr[i].z, gvr[i].w};
            float v[8];
#pragma unroll
            for (int p = 0; p < 4; ++p) { v[2 * p] = fmaf(fmaf(ST_LO(ww[p]), rs[2 * p], nmr[2 * p]), g, b); v[2 * p + 1] = fmaf(fmaf(ST_HI(ww[p]), rs[2 * p + 1], nmr[2 * p + 1]), g, b); }
            u32x4 o; o.x = ST_PK(v[0], v[1]); o.y = ST_PK(v[2], v[3]); o.z = ST_PK(v[4], v[5]); o.w = ST_PK(v[6], v[7]);
            *(LAS u32x4*)(lds + P2_BIMG + (rg * P2_PITCH + (ck << 4)) + i * (32 * P2_PITCH)) = o;
        }
        __builtin_amdgcn_sched_barrier(0);
        {
            const int it2 = it + p2G;
            if (it2 < 1024) {
                const char* gbase2 = (const char*)F.GVt + (size_t)((it2 >> 3) * 8 + (it2 & 7)) * 65536;
#pragma unroll
                for (int i = 0; i < 8; ++i) gvr[i] = *(const u32x4*)(gbase2 + (size_t)i * (32 * 128 * 2) + gvo);
            }
        }
        LDS_BARRIER();
        bf16x8 Bf[2][4];
        const int brow = 32 * w + 8 * (fr >> 2) + (fr & 3);
        const LAS unsigned char* bptr = lds + P2_BIMG + brow * P2_PITCH + (fq << 4);
        const LAS unsigned char* wptr = lds + P2_WIMG + fr * P2_PITCH + (fq << 4);
#pragma unroll
        for (int itl = 0; itl < 2; ++itl)
#pragma unroll
            for (int kk = 0; kk < 4; ++kk) Bf[itl][kk] = *(const LAS bf16x8*)(bptr + itl * (4 * P2_PITCH) + kk * 64);
        f32x4 acc[8][2];
#pragma unroll
        for (int m = 0; m < 8; ++m) { const float bs = ((const LAS float*)(lds + P2_TAB))[512 + fr + 16 * m]; acc[m][0] = (f32x4){bs, bs, bs, bs}; acc[m][1] = (f32x4){bs, bs, bs, bs}; }
#pragma unroll
        for (int m = 0; m < 8; ++m) {
            __builtin_amdgcn_sched_barrier(0);
#pragma unroll
            for (int kk = 0; kk < 4; ++kk) {
                if (kk <= (m >> 1)) {
                    const bf16x8 wf = *(const LAS bf16x8*)(wptr + m * (16 * P2_PITCH) + kk * 64);
                    acc[m][0] = MFMA_16(Bf[0][kk], wf, acc[m][0]);
                    acc[m][1] = MFMA_16(Bf[1][kk], wf, acc[m][1]);
                }
            }
        }
        __builtin_amdgcn_sched_barrier(0);
#pragma unroll
        for (int m = 0; m < 8; ++m) {
            const float bs = 0.f;
            const u32x4 e = ew[m];
            u32x4 o;
            o.x = OP_PK(ST_LO(e.x) * (acc[m][0][0] + bs), ST_HI(e.x) * (acc[m][0][1] + bs));
            o.y = OP_PK(ST_LO(e.y) * (acc[m][0][2] + bs), ST_HI(e.y) * (acc[m][0][3] + bs));
            o.z = OP_PK(ST_LO(e.z) * (acc[m][1][0] + bs), ST_HI(e.z) * (acc[m][1][1] + bs));
            o.w = OP_PK(ST_LO(e.w) * (acc[m][1][2] + bs), ST_HI(e.w) * (acc[m][1][3] + bs));
            *(u32x4*)(ybase + (size_t)m * (16 * D * 2) + evo) = o;
        }
    }
    __syncthreads();
}
__device__ __forceinline__ void p2_fix(Frame& F) {
    int tid = threadIdx.x; asm volatile("" : "+v"(tid));
    const int r = tid >> 8, ch = (tid & 255) * 8;
    const bf16_t* HALO = F.FIX; const bf16_t* H01 = F.FIX + 64 * 2 * D; const bf16_t* G01 = F.FIX + 2 * 64 * 2 * D;
    for (int pm = F.bx; pm < 64; pm += F.G) {
        const bool first = (pm & 31) == 0;
        const u32x4 z4 = (u32x4){0u, 0u, 0u, 0u};
        const u32x4 hA = first ? z4 : *(const u32x4*)(HALO + ((size_t)(pm - 1) * 2 + 0) * D + ch);
        const u32x4 hB = first ? z4 : *(const u32x4*)(HALO + ((size_t)(pm - 1) * 2 + 1) * D + ch);
        const u32x4 h00 = *(const u32x4*)(H01 + ((size_t)pm * 2 + 0) * D + ch), h01 = *(const u32x4*)(H01 + ((size_t)pm * 2 + 1) * D + ch);
        const u32x4 gv = *(const u32x4*)(G01 + ((size_t)pm * 2 + r) * D + ch);
        const u32x4 v0 = r == 0 ? h00 : h01, v1 = r == 0 ? hB : h00, v2 = r == 0 ? hA : hB;
        const unsigned a0[4] = {v0.x, v0.y, v0.z, v0.w}, a1[4] = {v1.x, v1.y, v1.z, v1.w}, a2[4] = {v2.x, v2.y, v2.z, v2.w}, ag[4] = {gv.x, gv.y, gv.z, gv.w};
        unsigned o[4];
#pragma unroll
        for (int p = 0; p < 4; ++p) {
            const int c0 = ch + 2 * p;
            const float y0 = ST_LO(ag[p]) * (F.conv_b[c0] + F.conv_w[c0] * ST_LO(a2[p]) + F.conv_w[D + c0] * ST_LO(a1[p]) + F.conv_w[2 * D + c0] * ST_LO(a0[p]));
            const float y1 = ST_HI(ag[p]) * (F.conv_b[c0 + 1] + F.conv_w[c0 + 1] * ST_HI(a2[p]) + F.conv_w[D + c0 + 1] * ST_HI(a1[p]) + F.conv_w[2 * D + c0 + 1] * ST_HI(a0[p]));
            o[p] = OP_PK(y0, y1);
        }
        *(u32x4*)(F.YB + (size_t)(pm * 256 + r) * D + ch) = (u32x4){o[0], o[1], o[2], o[3]};
    }
}

__device__ __forceinline__ void p5_ln(Frame& F) {
    int tid = threadIdx.x; asm volatile("" : "+v"(tid));
    const int lane = tid & 63, gw = F.bx * 8 + __builtin_amdgcn_readfirstlane(tid >> 6), NGW = F.G * 8;
    f32x4 g[8], b[8];
#pragma unroll
    for (int j = 0; j < 8; ++j) { g[j] = *(const f32x4*)(F.ln_g + 4 * lane + 256 * j); b[j] = *(const f32x4*)(F.ln_b + 4 * lane + 256 * j); }
    for (int row = gw; row < M; row += NGW) {
        const float* xp = F.x + (size_t)row * D + 4 * lane; const bf16_t* op = F.OUTB + (size_t)row * D + 4 * lane; float* rp = F.out + (size_t)row * D + 4 * lane;
        f32x4 v[8]; u32x2 o[8];
#if MK_F16S && MK_NBI < 32 && MK_P5XH
        {
            const bf16_t* hp = F.Xb + (size_t)row * D + 4 * lane; u32x2 xh[8];
#pragma unroll
            for (int j = 0; j < 8; ++j) { xh[j] = *(const u32x2*)(hp + 256 * j); o[j] = *(const u32x2*)(op + 256 * j); }
#pragma unroll
            for (int j = 0; j < 8; ++j) v[j] = (f32x4){ST_LO(xh[j].x), ST_HI(xh[j].x), ST_LO(xh[j].y), ST_HI(xh[j].y)};
        }
        (void)xp;
#else
#pragma unroll
        for (int j = 0; j < 8; ++j) { v[j] = *(const f32x4*)(xp + 256 * j); o[j] = *(const u32x2*)(op + 256 * j); }
#endif
        float s = 0.f;
#pragma unroll
        for (int j = 0; j < 8; ++j) { v[j] = v[j] * DN_ALPHA + (f32x4){ST_LO(o[j].x), ST_HI(o[j].x), ST_LO(o[j].y), ST_HI(o[j].y)}; s += (v[j][0] + v[j][1]) + (v[j][2] + v[j][3]); }
#pragma unroll
        for (int of = 1; of < 64; of <<= 1) s += __shfl_xor(s, of);
        const float mean = s * (1.f / D); float q = 0.f;
#pragma unroll
        for (int j = 0; j < 8; ++j) { v[j] = v[j] - mean; q += (v[j][0] * v[j][0] + v[j][1] * v[j][1]) + (v[j][2] * v[j][2] + v[j][3] * v[j][3]); }
#pragma unroll
        for (int of = 1; of < 64; of <<= 1) q += __shfl_xor(q, of);
        const float rstd = rsqrtf(q * (1.f / D) + LN_EPS);
#pragma unroll
        for (int j = 0; j < 8; ++j) *(f32x4*)(rp + 256 * j) = v[j] * rstd * g[j] + b[j];
    }
}

struct Args { const float* in[14]; float* out; unsigned char* ws; int ph_lo, ph_hi; };
__global__ void __launch_bounds__(512, 2) mk_fwd(Args args) {
    extern __shared__ __attribute__((aligned(16))) unsigned char lds_raw[];
    Frame F;
    F.lds = (LAS unsigned char*)lds_raw;
    F.tid = threadIdx.x; F.lane = F.tid & 63; F.wave = __builtin_amdgcn_readfirstlane(F.tid >> 6); F.G = gridDim.x; F.bx = blockIdx.x;
    unsigned char* ws = args.ws;
    F.x = args.in[0]; F.w_in = args.in[1]; F.b_gate = args.in[2]; F.ln_v_g = args.in[3]; F.ln_v_b = args.in[4]; F.w_s = args.in[5]; F.b_s = args.in[6];
    F.conv_w = args.in[7]; F.conv_b = args.in[8]; F.w_oa = args.in[9]; F.w_ob = args.in[10]; F.w_out = args.in[11]; F.ln_g = args.in[12]; F.ln_b = args.in[13];
    F.out = args.out;
    F.Woa_t = (bf16_t*)(ws + WS_WOA); F.Wob_t = (bf16_t*)(ws + WS_WOB); F.Wout_t = (bf16_t*)(ws + WS_WOUT);
    F.Xb = (bf16_t*)(ws + WS_XB); F.EW = (bf16_t*)(ws + WS_EW); F.GVt = (bf16_t*)(ws + WS_GVT); F.FIX = (bf16_t*)(ws + WS_FIX);
    F.RT = (bf16_t*)(ws + WS_RT); F.GBb = (bf16_t*)(ws + WS_GB); F.YA = (bf16_t*)(ws + WS_YA); F.YB = (bf16_t*)(ws + WS_YB); F.MG = (bf16_t*)(ws + WS_MG);
    F.OUTB = (bf16_t*)(ws + WS_OUTB); F.Wi8 = ws + WS_WI8; F.Win_t = (bf16_t*)(ws + WS_WBF); F.Xi8 = ws + WS_XQ; F.SX = (float*)(ws + WS_SX); F.SW = (float*)(ws + WS_SW);
    for (int u = F.tid; u < (LDS_BYTES - LDSCTL_OFF) / 4; u += 512) ((LAS unsigned*)(F.lds + LDSCTL_OFF))[u] = 0u;
    __syncthreads();
    const int lo = args.ph_lo, hi = args.ph_hi;
    XcdBarrier bar; bar.bar = (unsigned*)(ws + WS_CTL); bar.x = 0; bar.st = nullptr;
    if (hi - lo > 1) bar = xcd_barrier_post((unsigned*)(ws + WS_CTL), (volatile LAS unsigned*)(F.lds + MISC_OFF));
#ifndef PH_MASK
#define PH_MASK 63
#endif
#define IN(k) (((PH_MASK >> (k)) & 1) && lo <= (k) && (k) < hi)
#define GRID_BAR(k) do { if (IN(k) && IN((k) + 1)) { xcd_barrier(bar); if (MK_DOUBLE == 20) xcd_barrier(bar); } } while (0)
#ifndef MK_DOUBLE
#define MK_DOUBLE -1
#endif
    if (IN(0)) { p0_prologue<7>(F); if (MK_DOUBLE == 0) { __syncthreads(); p0_prologue<7>(F); } if (MK_DOUBLE == 11) { __syncthreads(); p0_prologue<1>(F); } if (MK_DOUBLE == 12) { __syncthreads(); p0_prologue<2>(F); } if (MK_DOUBLE == 13) { __syncthreads(); p0_prologue<4>(F); } }
    GRID_BAR(0);
    if (IN(1)) { ProgP1 P{F.Xi8, F.Wi8, F.SX, F.SW, F.EW, F.GVt, F.YB, F.FIX, F.RT, F.GBb, F.b_gate, F.conv_w, F.conv_b, F.lds + HL_OFF, F.G, F.bx, (void*)(ws + WS_CTL + 49152)}; pg8::gemm_phase(F.lds, P); if (MK_DOUBLE == 1) pg8::gemm_phase(F.lds, P);
                 if (MK_NBI < 32) { ProgP1B PB{F.Xb, F.Win_t, F.YB, F.FIX, F.conv_w, F.conv_b, F.lds + HL_OFF, F.G, F.bx}; pg8::gemm_phase(F.lds, PB); if (MK_DOUBLE == 8) pg8::gemm_phase(F.lds, PB); }
                 if (MK_DOUBLE == 14) { ProgP4 P4{F.Xb, F.Wout_t, (bf16_t*)F.out, F.G, F.bx}; pg8::gemm_phase(F.lds, P4); } }
    GRID_BAR(1);
    if (IN(2)) { p2_fix(F); p2_sgu(F); if (MK_DOUBLE == 2) { p2_fix(F); p2_sgu(F); } }
    GRID_BAR(2);
    if (IN(3)) { ProgP3 P{F.YA, F.YB, F.Woa_t, F.Wob_t, F.RT, F.GBb, F.MG, F.G, F.bx}; pg8::gemm_phase(F.lds, P); if (MK_DOUBLE == 3) pg8::gemm_phase(F.lds, P); }
    GRID_BAR(3);
    if (IN(4)) { ProgP4 P{F.MG, F.Wout_t, F.OUTB, F.G, F.bx}; pg8::gemm_phase(F.lds, P); if (MK_DOUBLE == 4) pg8::gemm_phase(F.lds, P); }
    GRID_BAR(4);
    if (IN(5)) { p5_ln(F); if (MK_DOUBLE == 7) p5_ln(F); }
    if (MK_DOUBLE == 15) { ProgP1B PB{F.Xb, F.Win_t, F.YB, F.FIX, F.conv_w, F.conv_b, F.lds + HL_OFF, F.G, F.bx}; pg8::gemm_phase(F.lds, PB); }
    if (MK_DOUBLE == 17) { ProgP4 P4{F.MG, F.Wout_t, F.YB, F.G, F.bx}; pg8::gemm_phase(F.lds, P4); }
    if (MK_DOUBLE == 18) { ProgP4 P4{F.YB, F.Wout_t, F.MG, F.G, F.bx}; pg8::gemm_phase(F.lds, P4); }
    if (MK_DOUBLE == 19) { ProgP4 P4{F.MG, F.Wout_t, F.OUTB, F.G, F.bx}; pg8::gemm_phase(F.lds, P4); }
    if (MK_DOUBLE == 16) { ProgP4 P4{F.Xb, F.Wout_t, F.MG, F.G, F.bx}; pg8::gemm_phase(F.lds, P4); }
#undef IN
#undef GRID_BAR
}


extern "C" void kernel_launch(void* const* d_in, const int* in_sizes, int n_in, void* d_out, int out_size, void* d_ws, size_t ws_size, hipStream_t stream) {
    static int grid = 0;
    if (grid == 0) {
        if (n_in != 14 || in_sizes[0] != M * D || out_size != M * D || ws_size < WS_END) {
            fprintf(stderr, "kernel_launch: unexpected shapes: n_in %d in0 %d out %d ws %zu (need %zu)\n", n_in, n_in > 0 ? in_sizes[0] : -1, out_size, ws_size, (size_t)WS_END); grid = -1; return; }
        int dev = 0, cus = 0, per_cu = 0;
        if (hipGetDevice(&dev) != hipSuccess || hipDeviceGetAttribute(&cus, hipDeviceAttributeMultiprocessorCount, dev) != hipSuccess) { grid = -1; return; }
        if (hipFuncSetAttribute((const void*)mk_fwd, hipFuncAttributeMaxDynamicSharedMemorySize, LDS_BYTES) != hipSuccess) { fprintf(stderr, "kernel_launch: hipFuncSetAttribute failed\n"); grid = -1; return; }
        if (hipOccupancyMaxActiveBlocksPerMultiprocessor(&per_cu, (const void*)mk_fwd, 512, LDS_BYTES) != hipSuccess || per_cu < 1) {
            fprintf(stderr, "kernel_launch: occupancy query says %d blocks per CU; cannot run the persistent grid\n", per_cu); (void)hipGetLastError(); grid = -1; return; }
        grid = cus;
        if (grid % 8 != 0) fprintf(stderr, "kernel_launch: note: grid %d is not a multiple of 8\n", grid);
    }
    if (grid < 0) return;
    (void)hipMemsetAsync((char*)d_ws + WS_CTL, 0, CTL_ZERO_BYTES, stream);
    Args a{};
    for (int i = 0; i < 14; ++i) a.in[i] = (const float*)d_in[i];
    a.out = (float*)d_out; a.ws = (unsigned char*)d_ws;
    if (MK_N_LAUNCHES == 1) {
        a.ph_lo = 0; a.ph_hi = NPH;
        hipLaunchKernelGGL(mk_fwd, dim3(grid), dim3(512), LDS_BYTES, stream, a);
    } else {
        for (int p = 0; p < NPH; ++p) { a.ph_lo = p; a.ph_hi = p + 1; hipLaunchKernelGGL(mk_fwd, dim3(grid), dim3(512), LDS_BYTES, stream, a); }
    }
    const hipError_t le = hipPeekAtLastError();
    if (le != hipSuccess) fprintf(stderr, "kernel_launch: launch failed: %s\n", hipGetErrorName(le));
}
```
